# Optimizing an MI355X kernel written in HIP

```python
import jax, jax.numpy as jnp
from jax import lax
import numpy as np

D_MODEL = 1024
BATCH = 2
SEQ = 16384
DEPTH = 1
DEC_BATCH = 8
DEC_SEQ = 64
PAST_LEN = 1024

CHUNK = 64
Q_BLOCK = 128
N_HEADS = 8
QK_NOPE = 64
QK_ROPE = 32
QK_HEAD = QK_NOPE + QK_ROPE
V_HEAD = 64
Q_LORA = 384
KV_LORA = 256
ROPE_THETA = 10000.0
D_RNN = D_MODEL
RNN_BLOCKS = 8
RNN_BLOCK = D_RNN // RNN_BLOCKS
CONV_W = 4
LRU_C = 8.0
D_FF = 2816
EPS = 1e-6
OFF_Q = 0
OFF_KV = OFF_Q + Q_LORA
OFF_KR = OFF_KV + KV_LORA
OFF_RX = OFF_KR + QK_ROPE
OFF_RG = OFF_RX + D_RNN
OFF_GA = OFF_RG + D_RNN
OFF_GB = OFF_GA + D_MODEL
D_IN = OFF_GB + D_MODEL

kernel_name = "streaming_mla_rglru_macaron_step"


def rmsnorm(x, g):
    xf = x.astype(jnp.float32)
    y = xf * lax.rsqrt(jnp.mean(xf * xf, axis=-1, keepdims=True) + EPS)
    return (y * g.astype(jnp.float32)).astype(x.dtype)


def swiglu_half(x, g, w1, w3, w2):
    h = rmsnorm(x, g)
    return x + 0.5 * ((jax.nn.silu(h @ w1) * (h @ w3)) @ w2)


def rope_tables(pos):
    inv = 1.0 / (ROPE_THETA ** (jnp.arange(0, QK_ROPE, 2, dtype=jnp.float32) / QK_ROPE))
    ang = pos.astype(jnp.float32)[:, None] * inv[None, :]
    return jnp.cos(ang), jnp.sin(ang)


def apply_rope(x, cos, sin):
    x1, x2 = jnp.split(x.astype(jnp.float32), 2, axis=-1)
    return jnp.concatenate([x1 * cos - x2 * sin, x2 * cos + x1 * sin], axis=-1).astype(x.dtype)


def mla_qkr(z, pos, p):
    B, S = z.shape[:2]
    cos, sin = rope_tables(pos)
    q = (rmsnorm(z[..., OFF_Q:OFF_KV], p["norm_q"]) @ p["w_uq"]).reshape(B, S, N_HEADS, QK_HEAD)
    q = jnp.concatenate([q[..., :QK_NOPE],
                         apply_rope(q[..., QK_NOPE:], cos[None, :, None], sin[None, :, None])], axis=-1)
    c_kv = rmsnorm(z[..., OFF_KV:OFF_KR], p["norm_kv"])
    k_r = apply_rope(z[..., OFF_KR:OFF_RX], cos[None], sin[None])
    return q, c_kv, k_r


def mla_keys(c_kv, k_r, p):
    B, T = c_kv.shape[:2]
    kv = (c_kv @ p["w_ukv"]).reshape(B, T, N_HEADS, QK_NOPE + V_HEAD)
    k = jnp.concatenate([kv[..., :QK_NOPE],
                         jnp.broadcast_to(k_r[:, :, None, :], (B, T, N_HEADS, QK_ROPE))], axis=-1)
    return k, kv[..., QK_NOPE:]


def attend(q, k, v, mask):
    s = jnp.einsum("bqhd,bkhd->bhqk", q, k).astype(jnp.float32) * (QK_HEAD ** -0.5)
    if mask is not None:
        s = jnp.where(mask, s, -jnp.inf)
    pr = jax.nn.softmax(s, axis=-1).astype(v.dtype)
    return jnp.einsum("bhqk,bkhd->bqhd", pr, v)


def chunk_causal_attention(q, k, v):
    B, S = q.shape[:2]
    k_chunk = jnp.arange(S) // CHUNK

    def one_block(i):
        start = i * Q_BLOCK
        qb = lax.dynamic_slice_in_dim(q, start, Q_BLOCK, axis=1)
        q_chunk = (start + jnp.arange(Q_BLOCK)) // CHUNK
        mask = k_chunk[None, :] <= q_chunk[:, None]
        return attend(qb, k, v, mask[None, None])

    o = lax.map(one_block, jnp.arange(S // Q_BLOCK))
    return o.transpose(1, 0, 2, 3, 4).reshape(B, S, N_HEADS, V_HEAD)


def rglru_branch(xr, conv_buf, h0, reset, p):
    B, S = xr.shape[:2]
    xp = jnp.concatenate([conv_buf.astype(xr.dtype), xr], axis=1)
    xc = p["conv_b"] + sum(xp[:, j:j + S] * p["conv_w"][j] for j in range(CONV_W))
    new_buf = xp[:, S:]
    xb = xc.reshape(B, S, RNN_BLOCKS, RNN_BLOCK)
    r = jax.nn.sigmoid(jnp.einsum("bsni,nij->bsnj", xb, p["w_rgate"]).reshape(B, S, D_RNN) + p["b_rgate"])
    ig = jax.nn.sigmoid(jnp.einsum("bsni,nij->bsnj", xb, p["w_igate"]).reshape(B, S, D_RNN) + p["b_igate"])
    log_a = -LRU_C * r.astype(jnp.float32) * jax.nn.softplus(-p["lru_lambda"].astype(jnp.float32))
    rs = reset[None, :, None]
    a = jnp.where(rs, 0.0, jnp.exp(log_a))
    mult = jnp.where(rs, 1.0, jnp.sqrt(-jnp.expm1(2.0 * log_a)))
    bterm = mult * (ig * xc).astype(jnp.float32)
    bterm = bterm.at[:, 0].add(a[:, 0] * h0.astype(jnp.float32))

    def combine(lhs, rhs):
        a1, b1 = lhs
        a2, b2 = rhs
        return a1 * a2, a2 * b1 + b2

    _, h = lax.associative_scan(combine, (a, bterm), axis=1)
    return h.astype(xr.dtype), new_buf, h[:, -1].astype(xr.dtype)


def layer(x, pos, reset, cache_c, cache_kr, conv_buf, h0, p):
    B, S = x.shape[:2]
    x = swiglu_half(x, p["norm_ffn1"], p["w1_ffn1"], p["w3_ffn1"], p["w2_ffn1"])
    u = rmsnorm(x, p["norm_mix"])
    z = u @ p["w_in"]
    q, c_new, kr_new = mla_qkr(z, pos, p)
    if cache_c is None:
        k, v = mla_keys(c_new, kr_new, p)
        o = chunk_causal_attention(q, k, v)
    else:
        k, v = mla_keys(jnp.concatenate([cache_c.astype(c_new.dtype), c_new], axis=1),
                        jnp.concatenate([cache_kr.astype(kr_new.dtype), kr_new], axis=1), p)
        o = attend(q, k, v, None)
    y_attn = o.reshape(B, S, N_HEADS * V_HEAD) @ p["w_o_attn"]
    h, new_buf, h_last = rglru_branch(z[..., OFF_RX:OFF_RG], conv_buf, h0, reset, p)
    y_rnn = (h * jax.nn.gelu(z[..., OFF_RG:OFF_GA], approximate=True)) @ p["w_o_rnn"]
    m = jax.nn.sigmoid(z[..., OFF_GA:OFF_GB]) * y_attn + jax.nn.sigmoid(z[..., OFF_GB:D_IN]) * y_rnn
    x = x + m @ p["w_out"]
    x = swiglu_half(x, p["norm_ffn2"], p["w1_ffn2"], p["w3_ffn2"], p["w2_ffn2"])
    return x, c_new, kr_new, new_buf, h_last


def setup_inputs(seed: int = 0) -> dict:
    key = jax.random.key(seed)
    ks = iter(jax.random.split(key, 48))
    f32 = jnp.float32
    L = DEPTH

    def w(shape, fan_in):
        return jax.random.normal(next(ks), shape, f32) * fan_in ** -0.5

    def gain(shape):
        return 1.0 + 0.01 * jax.random.normal(next(ks), shape, f32)

    def bias(shape):
        return 0.01 * jax.random.normal(next(ks), shape, f32)

    x_prompt = jax.random.normal(next(ks), (BATCH, SEQ, D_MODEL), f32)
    x_sample = jax.random.normal(next(ks), (DEC_BATCH, DEC_SEQ, D_MODEL), f32)
    cache_kv_latent = jax.random.normal(next(ks), (L, DEC_BATCH, PAST_LEN, KV_LORA), f32)
    cache_k_rope = jax.random.normal(next(ks), (L, DEC_BATCH, PAST_LEN, QK_ROPE), f32)
    state_conv = jax.random.normal(next(ks), (L, DEC_BATCH, CONV_W - 1, D_RNN), f32)
    state_rglru = 0.5 * jax.random.normal(next(ks), (L, DEC_BATCH, D_RNN), f32)
    a_target = jax.random.uniform(next(ks), (L, D_RNN), f32, 0.9, 0.999)
    a_base = a_target ** (1.0 / LRU_C)
    lru_lambda = jnp.log(a_base) - jnp.log1p(-a_base)
    return {
        "x_prompt": x_prompt, "x_sample": x_sample,
        "cache_kv_latent": cache_kv_latent, "cache_k_rope": cache_k_rope,
        "state_conv": state_conv, "state_rglru": state_rglru,
        "norm_ffn1": gain((L, D_MODEL)),
        "w1_ffn1": w((L, D_MODEL, D_FF), D_MODEL), "w3_ffn1": w((L, D_MODEL, D_FF), D_MODEL),
        "w2_ffn1": w((L, D_FF, D_MODEL), D_FF),
        "norm_mix": gain((L, D_MODEL)), "w_in": w((L, D_MODEL, D_IN), D_MODEL),
        "norm_q": gain((L, Q_LORA)), "w_uq": w((L, Q_LORA, N_HEADS * QK_HEAD), Q_LORA),
        "norm_kv": gain((L, KV_LORA)), "w_ukv": w((L, KV_LORA, N_HEADS * (QK_NOPE + V_HEAD)), KV_LORA),
        "w_o_attn": w((L, N_HEADS * V_HEAD, D_MODEL), N_HEADS * V_HEAD),
        "conv_w": w((L, CONV_W, D_RNN), CONV_W), "conv_b": bias((L, D_RNN)),
        "w_rgate": w((L, RNN_BLOCKS, RNN_BLOCK, RNN_BLOCK), RNN_BLOCK), "b_rgate": bias((L, D_RNN)),
        "w_igate": w((L, RNN_BLOCKS, RNN_BLOCK, RNN_BLOCK), RNN_BLOCK), "b_igate": bias((L, D_RNN)),
        "lru_lambda": lru_lambda, "w_o_rnn": w((L, D_RNN, D_MODEL), D_RNN),
        "w_out": w((L, D_MODEL, D_MODEL), D_MODEL),
        "norm_ffn2": gain((L, D_MODEL)),
        "w1_ffn2": w((L, D_MODEL, D_FF), D_MODEL), "w3_ffn2": w((L, D_MODEL, D_FF), D_MODEL),
        "w2_ffn2": w((L, D_FF, D_MODEL), D_FF),
        "norm_final": gain((D_MODEL,)),
    }


def reference(x_prompt, x_sample, cache_kv_latent, cache_k_rope, state_conv, state_rglru,
              norm_ffn1, w1_ffn1, w3_ffn1, w2_ffn1, norm_mix, w_in,
              norm_q, w_uq, norm_kv, w_ukv, w_o_attn,
              conv_w, conv_b, w_rgate, b_rgate, w_igate, b_igate, lru_lambda, w_o_rnn,
              w_out, norm_ffn2, w1_ffn2, w3_ffn2, w2_ffn2, norm_final):
    Bp, Sp = x_prompt.shape[:2]
    Bs, Ss = x_sample.shape[:2]
    past = cache_kv_latent.shape[2]
    pos_p = jnp.arange(Sp)
    pos_s = past + jnp.arange(Ss)
    reset_p = pos_p == 0
    reset_s = jnp.zeros((Ss,), dtype=bool)
    hp, hs = x_prompt, x_sample
    cp, krp, cbp, hlp = [], [], [], []
    cs, krs, cbs, hls = [], [], [], []
    for l in range(DEPTH):
        p = dict(norm_ffn1=norm_ffn1[l], w1_ffn1=w1_ffn1[l], w3_ffn1=w3_ffn1[l], w2_ffn1=w2_ffn1[l],
                 norm_mix=norm_mix[l], w_in=w_in[l], norm_q=norm_q[l], w_uq=w_uq[l],
                 norm_kv=norm_kv[l], w_ukv=w_ukv[l], w_o_attn=w_o_attn[l],
                 conv_w=conv_w[l], conv_b=conv_b[l], w_rgate=w_rgate[l], b_rgate=b_rgate[l],
                 w_igate=w_igate[l], b_igate=b_igate[l], lru_lambda=lru_lambda[l], w_o_rnn=w_o_rnn[l],
                 w_out=w_out[l], norm_ffn2=norm_ffn2[l], w1_ffn2=w1_ffn2[l], w3_ffn2=w3_ffn2[l],
                 w2_ffn2=w2_ffn2[l])
        zero_buf = jnp.zeros((Bp, CONV_W - 1, D_RNN), x_prompt.dtype)
        zero_h = jnp.zeros((Bp, D_RNN), x_prompt.dtype)
        hp, c1, k1, b1, h1 = layer(hp, pos_p, reset_p, None, None, zero_buf, zero_h, p)
        hs, c2, k2, b2, h2 = layer(hs, pos_s, reset_s, cache_kv_latent[l], cache_k_rope[l],
                                   state_conv[l], state_rglru[l], p)
        cp.append(c1); krp.append(k1); cbp.append(b1); hlp.append(h1)
        cs.append(c2); krs.append(k2); cbs.append(b2); hls.append(h2)
    y_prompt = rmsnorm(hp, norm_final)
    y_sample = rmsnorm(hs, norm_final)
    return (y_prompt, y_sample,
            jnp.stack(cp), jnp.stack(krp), jnp.stack(cbp), jnp.stack(hlp),
            jnp.stack(cs), jnp.stack(krs), jnp.stack(cbs), jnp.stack(hls))
```

```cpp
#include <hip/hip_runtime.h>
#include <hip/hip_cooperative_groups.h>
#include <cstdio>
#include <cstdint>
namespace cg = cooperative_groups;

#ifndef MK_DUP
#define MK_DUP -1
#endif
#ifndef MK_ONE_LAUNCH
#define MK_ONE_LAUNCH 1
#endif

#define LAS __attribute__((address_space(3)))
typedef unsigned short bf16_t;
typedef short bf16x8 __attribute__((ext_vector_type(8)));
typedef float f32x4 __attribute__((ext_vector_type(4)));
typedef float f32x2 __attribute__((ext_vector_type(2)));
typedef float f32x16 __attribute__((ext_vector_type(16)));
typedef unsigned u32x4 __attribute__((ext_vector_type(4)));
typedef unsigned u32x2 __attribute__((ext_vector_type(2)));
typedef __bf16 bf16x2_t __attribute__((ext_vector_type(2)));

constexpr int DM = 1024, SEQ = 16384, NBP = 2, MP = NBP * SEQ, SBATCH = 8, SSEQ = 64, MS = SBATCH * SSEQ, MT = MP + MS, PAST = 1024;
constexpr int DFF = 2816, ZW = 4864, SKV = PAST + SSEQ, KVROWS = MP + SBATCH * SKV;
constexpr float EPS = 1e-6f;
constexpr float LOG2E = 1.4426950408889634f;
constexpr float QSCALE = 0.10206207261596577f * LOG2E;
constexpr size_t O_Y = 0, O_KVP = (size_t)MT * DM, O_KRP = O_KVP + (size_t)MP * 256, O_CVP = O_KRP + (size_t)MP * 32, O_HP = O_CVP + 2 * 3 * 1024,
                 O_KVS = O_HP + 2 * 1024, O_KRS = O_KVS + (size_t)MS * 256, O_CVS = O_KRS + (size_t)MS * 32, O_HS = O_CVS + 8 * 3 * 1024;
constexpr size_t MiB = 1u << 20;
constexpr size_t WS_STAT = 0;
constexpr size_t WS_CS = 1 * MiB;
constexpr size_t WS_SP = 3 * MiB;
constexpr size_t WS_SA = 4 * MiB, WS_SB = 6 * MiB;
constexpr size_t WS_W = 8 * MiB;
constexpr size_t W_13A = WS_W, W_2A = W_13A + (size_t)5632 * 1024 * 2, W_IN = W_2A + (size_t)1024 * 2816 * 2, W_UQ = W_IN + (size_t)ZW * 1024 * 2,
                 W_KV = W_UQ + (size_t)768 * 384 * 2, W_G = W_KV + (size_t)1024 * 256 * 2, W_OA = W_G + (size_t)2048 * 128 * 2, W_OR = W_OA + (size_t)1024 * 512 * 2,
                 W_OUT = W_OR + (size_t)1024 * 1024 * 2, W_13B = W_OUT + (size_t)1024 * 1024 * 2, W_2B = W_13B + (size_t)5632 * 1024 * 2, W_END = W_2B + (size_t)1024 * 2816 * 2;
static_assert(W_END <= 60 * MiB, "weights");
constexpr size_t SZ_ROW1K = (size_t)MT * 1024 * 2;
constexpr size_t WS_AB = 60 * MiB;
constexpr size_t WS_ZA = WS_AB + 66 * MiB;
constexpr size_t WS_ZRX = WS_ZA + (size_t)MT * 768 * 2;
constexpr size_t WS_ZRG = WS_ZRX + SZ_ROW1K;
constexpr size_t WS_ZG8 = WS_ZRG + SZ_ROW1K;
constexpr size_t WS_XC = WS_ZG8 + SZ_ROW1K;
constexpr size_t WS_CKV = WS_XC + SZ_ROW1K;
constexpr size_t WS_KR = WS_CKV + (size_t)KVROWS * 256 * 2;
constexpr size_t WS_END = WS_KR + (size_t)KVROWS * 32 * 2;
static_assert(WS_END <= 512 * MiB, "d_ws map");
static_assert(SZ_ROW1K <= 66 * MiB, "AB region");

__device__ __forceinline__ unsigned pk2(float lo, float hi) { f32x2 v = {lo, hi}; bf16x2_t b = __builtin_convertvector(v, bf16x2_t); return __builtin_bit_cast(unsigned, b); }
__device__ __forceinline__ float bflo(unsigned w) { return __uint_as_float(w << 16); }
__device__ __forceinline__ float bfhi(unsigned w) { return __uint_as_float(w & 0xffff0000u); }
__device__ __forceinline__ float bf1(bf16_t u) { return __uint_as_float(((unsigned)u) << 16); }
__device__ __forceinline__ float sigmoidf_(float x) { return __builtin_amdgcn_rcpf(1.f + __builtin_amdgcn_exp2f(-x * LOG2E)); }
__device__ __forceinline__ float wave_sum(float v) {
#pragma unroll
    for (int o = 1; o < 64; o <<= 1) v += __shfl_xor(v, o);
    return v;
}

namespace pg8 {
constexpr int BM = 256, BK = 64, HALF = 128, HTB = HALF * BK * 2, NXCD = 8, WGM = 8;
__host__ __device__ __forceinline__ int lds_byte(int r, int c) { const int st = (r >> 4) * 2 + (c >> 5), rr = r & 15, cc = c & 31, ob = rr * 64 + cc * 2; return st * 1024 + (ob ^ (((ob >> 9) & 1) << 5)); }
__host__ __device__ __forceinline__ void stage_rc(int b, int& R, int& C) { const int st = b / 1024, sb = b % 1024, swz = sb ^ (((sb >> 9) & 1) << 5); R = (st >> 1) * 16 + swz / 64; C = (st & 1) * 32 + (swz % 64) / 2; }
__host__ __device__ __forceinline__ int perm32(int rho) { const int n = rho >> 4, i = rho & 15; return 8 * (i >> 2) + 4 * n + (i & 3); }
struct Unit { int pm, pn, ks, nk, split; };
struct Gemm { const bf16_t* A; const bf16_t* Bt; int M, N, K, lda, ldb, a_pn_off; float* accbuf; unsigned* cnt; };
struct StaticOrder {
    int nM, nN, nwg, G, c, nt, NS, nmain;
    __device__ __forceinline__ void init(int M, int N, int K, int G_, int c_, int NS_ = 0) { nM = M / BM; nN = N / BM; nt = K / BK; NS = NS_; G = G_; c = c_;
        if (NS) { nM = 128; nmain = nM * nN; nwg = nmain + 2 * nN * NS; } else { nmain = nM * nN; nwg = nmain; } }
    __device__ __forceinline__ bool next(int i, Unit& u) const {
        const long L = (long)i * G + c; if (L >= nwg) return false;
        const bool sp = L >= nmain;
        const int NSd = NS ? NS : 1, j = sp ? (int)L - nmain : 0, uu = j / NSd, sl = j - uu * NSd, nks = nt / NSd;
        int wgid = sp ? 0 : (int)L; { const int q = nmain / NXCD, r = nmain % NXCD, xcd = wgid % NXCD, off = wgid / NXCD; wgid = (xcd < r ? xcd * (q + 1) : r * (q + 1) + (xcd - r) * q) + off; }
        const int nig = WGM * nN, gid = wgid / nig, fm = gid * WGM, gsz = (nM - fm) < WGM ? (nM - fm) : WGM;
        const int pm_m = fm + ((wgid % nig) % gsz), pn_m = (wgid % nig) / gsz;
        u.pm = __builtin_amdgcn_readfirstlane(sp ? 128 + uu / nN : pm_m); u.pn = __builtin_amdgcn_readfirstlane(sp ? uu % nN : pn_m);
        u.ks = __builtin_amdgcn_readfirstlane(sp ? sl * nks : 0); u.nk = __builtin_amdgcn_readfirstlane(sp ? nks : nt); u.split = sp ? 1 : 0; return true;
    }
};
template <class Epi>
__device__ __forceinline__ void gemm_phase(LAS unsigned char* lds, const Gemm g, const StaticOrder& S, const Epi& E) {
    int tid_ = threadIdx.x; asm volatile("" : "+v"(tid_));
    const int tid = tid_, wid = __builtin_amdgcn_readfirstlane(tid >> 6), lane = tid & 63, wr = wid >> 2, wc = wid & 3, fr = lane & 15, fq = lane >> 4;
    unsigned voffA[2], voffB[2];
#pragma unroll
    for (int i = 0; i < 2; ++i) { int R, C; stage_rc(tid * 16 + i * 8192, R, C); const int Rb = (R & ~31) + perm32(R & 31);
        voffA[i] = (unsigned)(R * g.lda + C) * 2u; voffB[i] = (unsigned)(Rb * g.ldb + C) * 2u; }
    const size_t kstep = (size_t)(BK * 2);
    const size_t hstepA = (size_t)HALF * g.lda * 2, hstepB = (size_t)HALF * g.ldb * 2;
    const size_t tstepA = 2 * hstepA, tstepB = 2 * hstepB;
    const unsigned ldsb = (unsigned)__builtin_amdgcn_readfirstlane((int)((unsigned)(uintptr_t)lds + (unsigned)wid * 1024u));
    const int aoff = lds_byte(wr * 64 + fr, fq * 8), boff = lds_byte(wc * 32 + fr, fq * 8);
#define PG8_SA(b, h) (((b) * 2 + (h)) * HTB)
#define PG8_SB(b, h) ((4 + (b) * 2 + (h)) * HTB)
#define PG8_STAGE(bufoff, gbase, voff) do { _Pragma("unroll") for (int _i = 0; _i < 2; ++_i) { unsigned _keep; \
        asm volatile("s_mov_b32 %0, m0\n\ts_mov_b32 m0, %1\n\ts_nop 0\n\tglobal_load_lds_dwordx4 %2, %3\n\ts_mov_b32 m0, %0" : "=&s"(_keep) : "s"(ldsb + (unsigned)((bufoff) + _i * 8192)), "v"((voff)[_i]), "s"((const char*)(gbase)) : "memory"); } } while (0)
#define PG8_LDA(dst, b, h) do { _Pragma("unroll") for (int m = 0; m < 4; ++m) _Pragma("unroll") for (int k = 0; k < 2; ++k) dst[m][k] = *(const LAS bf16x8*)(lds + PG8_SA(b, h) + aoff + m * 2048 + k * 1024); } while (0)
#define PG8_LDB(dst, b, h) do { _Pragma("unroll") for (int n = 0; n < 2; ++n) _Pragma("unroll") for (int k = 0; k < 2; ++k) dst[n][k] = *(const LAS bf16x8*)(lds + PG8_SB(b, h) + boff + n * 2048 + k * 1024); } while (0)
#define PG8_MMA(ai, bj, At, Bt) do { __builtin_amdgcn_s_setprio(1); _Pragma("unroll") for (int m = 0; m < 4; ++m) _Pragma("unroll") for (int n = 0; n < 2; ++n) _Pragma("unroll") for (int k = 0; k < 2; ++k) \
        acc[ai][bj][m][n] = __builtin_amdgcn_mfma_f32_16x16x32_bf16(Bt[n][k], At[m][k], acc[ai][bj][m][n], 0, 0, 0); __builtin_amdgcn_s_setprio(0); } while (0)
#define PG8_WAIT_V(n) asm volatile("s_waitcnt vmcnt(" #n ")" ::: "memory")
#define PG8_WAIT_L(n) asm volatile("s_waitcnt lgkmcnt(" #n ")" ::: "memory")
#define PG8_BAR __builtin_amdgcn_s_barrier()
#define PG8_SCHED __builtin_amdgcn_sched_barrier(0)
    Unit cur, nxt; int ui = 0;
    if (!S.next(0, cur)) return;
    f32x4 acc[2][2][4][2];
#pragma unroll
    for (int a = 0; a < 2; ++a)
#pragma unroll
        for (int b = 0; b < 2; ++b)
#pragma unroll
            for (int m = 0; m < 4; ++m)
#pragma unroll
                for (int n = 0; n < 2; ++n) acc[a][b][m][n] = (f32x4){0.f, 0.f, 0.f, 0.f};
    bf16x8 At[4][2], B0[2][2], B1[2][2];
    const char* cA = (const char*)g.A + (size_t)cur.pm * tstepA + (size_t)cur.pn * g.a_pn_off * 2 + (size_t)cur.ks * kstep; const char* cB = (const char*)g.Bt + (size_t)cur.pn * tstepB + (size_t)cur.ks * kstep;
    PG8_STAGE(PG8_SB(0, 0), cB, voffB); PG8_STAGE(PG8_SB(0, 1), cB + hstepB, voffB); PG8_STAGE(PG8_SA(0, 0), cA, voffA); PG8_STAGE(PG8_SA(0, 1), cA + hstepA, voffA);
    if (wr == 1) PG8_BAR;
    PG8_WAIT_V(2); PG8_BAR;
    PG8_STAGE(PG8_SB(1, 0), cB + kstep, voffB); PG8_STAGE(PG8_SA(1, 0), cA + kstep, voffA); PG8_STAGE(PG8_SB(1, 1), cB + hstepB + kstep, voffB);
    PG8_WAIT_V(6); PG8_BAR;
    for (;;) {
        const bool has_next = S.next(ui + 1, nxt);
        const char* nA = has_next ? (const char*)g.A + (size_t)nxt.pm * tstepA + (size_t)nxt.pn * g.a_pn_off * 2 + (size_t)nxt.ks * kstep : cA; const char* nB = has_next ? (const char*)g.Bt + (size_t)nxt.pn * tstepB + (size_t)nxt.ks * kstep : cB;
        const int nt = cur.nk;
#pragma nounroll
        for (int t = 0; t < nt; t += 2) {
            const bool last = (t == nt - 2);
            const char* a1 = cA + (size_t)(t + 1) * kstep;
            const char* a2 = last ? nA : cA + (size_t)(t + 2) * kstep; const char* b2 = last ? nB : cB + (size_t)(t + 2) * kstep;
            const char* a3 = a2 + kstep; const char* b3 = b2 + kstep;
            PG8_LDB(B0, 0, 0); PG8_LDB(B1, 0, 1); PG8_SCHED; PG8_LDA(At, 0, 0); PG8_STAGE(PG8_SA(1, 1), a1 + hstepA, voffA);
            PG8_WAIT_V(8); PG8_WAIT_L(0); PG8_BAR; PG8_MMA(0, 0, At, B0); PG8_MMA(0, 1, At, B1); PG8_BAR; PG8_SCHED;
            PG8_LDA(At, 0, 1); PG8_STAGE(PG8_SB(0, 0), b2, voffB); PG8_STAGE(PG8_SB(0, 1), b2 + hstepB, voffB); PG8_STAGE(PG8_SA(0, 0), a2, voffA);
            PG8_WAIT_V(8); PG8_WAIT_L(0); PG8_BAR; PG8_MMA(1, 0, At, B0); PG8_MMA(1, 1, At, B1); PG8_BAR; PG8_SCHED;
            PG8_LDB(B0, 1, 0); PG8_LDB(B1, 1, 1); PG8_SCHED; PG8_LDA(At, 1, 0); PG8_STAGE(PG8_SA(0, 1), a2 + hstepA, voffA);
            PG8_WAIT_V(8); PG8_WAIT_L(0); PG8_BAR; PG8_MMA(0, 0, At, B0); PG8_MMA(0, 1, At, B1); PG8_BAR; PG8_SCHED;
            PG8_LDA(At, 1, 1); PG8_STAGE(PG8_SB(1, 0), b3, voffB); PG8_STAGE(PG8_SB(1, 1), b3 + hstepB, voffB); PG8_STAGE(PG8_SA(1, 0), a3, voffA);
            PG8_WAIT_V(8); PG8_WAIT_L(0); PG8_BAR; PG8_MMA(1, 0, At, B0); PG8_MMA(1, 1, At, B1); PG8_BAR; PG8_SCHED;
        }
        if (wr == 0) PG8_BAR;
        bool run_epi = true;
        if (cur.split) {
            const int tix = (cur.pm - 128) * S.nN + cur.pn, myslice = cur.ks / cur.nk;
            float* T = g.accbuf + (size_t)tix * S.NS * 65536; const unsigned toff = (unsigned)tid * 16u;
            { float* P = T + (size_t)myslice * 65536; const __amdgpu_buffer_rsrc_t prs = __builtin_amdgcn_make_buffer_rsrc((void*)P, 0, 262144, 0x00020000);
#pragma unroll
              for (int a = 0; a < 2; ++a)
#pragma unroll
                for (int m = 0; m < 4; ++m)
#pragma unroll
                    for (int b = 0; b < 2; ++b)
#pragma unroll
                        for (int n = 0; n < 2; ++n) __builtin_amdgcn_raw_buffer_store_b128(__builtin_bit_cast(u32x4, acc[a][b][m][n]), prs, (int)(toff + (((a * 4 + m) * 2 + b) * 2 + n) * 8192), 0, 16); }
            volatile LAS unsigned* flg = (volatile LAS unsigned*)(lds + 131072 + 16);
            PG8_WAIT_V(0); PG8_BAR;
            if (tid == 0) { const unsigned old = __hip_atomic_fetch_add(g.cnt + tix, 1u, __ATOMIC_RELAXED, __HIP_MEMORY_SCOPE_AGENT); *flg = (old == (unsigned)(S.NS - 1)) ? 1u : 0u; }
            PG8_WAIT_L(0); PG8_BAR;
            const unsigned lastf = (unsigned)__builtin_amdgcn_readfirstlane((int)*flg);
            run_epi = lastf != 0u;
            if (lastf) {
#pragma nounroll
                for (int sl = 0; sl < S.NS; ++sl) { if (sl == myslice) continue;
                    const __amdgpu_buffer_rsrc_t qrs = __builtin_amdgcn_make_buffer_rsrc((void*)(T + (size_t)sl * 65536), 0, 262144, 0x00020000);
#pragma unroll
                    for (int a = 0; a < 2; ++a)
#pragma unroll
                        for (int m = 0; m < 4; ++m)
#pragma unroll
                            for (int b = 0; b < 2; ++b)
#pragma unroll
                                for (int n = 0; n < 2; ++n) acc[a][b][m][n] += __builtin_bit_cast(f32x4, __builtin_amdgcn_raw_buffer_load_b128(qrs, (int)(toff + (((a * 4 + m) * 2 + b) * 2 + n) * 8192), 0, 16)); }
            }
            PG8_WAIT_L(0); PG8_BAR;
        }
        if (run_epi) E(acc, cur, wr, wc, fr, fq);
        if (!has_next) break;
#pragma unroll
        for (int a = 0; a < 2; ++a)
#pragma unroll
            for (int b = 0; b < 2; ++b)
#pragma unroll
                for (int m = 0; m < 4; ++m)
#pragma unroll
                    for (int n = 0; n < 2; ++n) acc[a][b][m][n] = (f32x4){0.f, 0.f, 0.f, 0.f};
        cur = nxt; cA = nA; cB = nB; ++ui;
        if (wr == 1) PG8_BAR;
    }
    PG8_WAIT_V(0);
    PG8_BAR;
#undef PG8_SA
#undef PG8_SB
#undef PG8_STAGE
#undef PG8_LDA
#undef PG8_LDB
#undef PG8_MMA
#undef PG8_WAIT_V
#undef PG8_WAIT_L
#undef PG8_BAR
#undef PG8_SCHED
}
}
using pg8::Unit;
typedef const f32x4 (&AccRef)[2][2][4][2];

#define EPI_ROWS(...) _Pragma("unroll") for (int ai = 0; ai < 2; ++ai) _Pragma("unroll") for (int m = 0; m < 4; ++m) { const int row = row0 + ai * 128 + m * 16; __VA_ARGS__ __builtin_amdgcn_sched_barrier(0); }
__device__ __forceinline__ u32x4 pack8(f32x4 a, f32x4 b) { u32x4 w; w.x = pk2(a[0], a[1]); w.y = pk2(a[2], a[3]); w.z = pk2(b[0], b[1]); w.w = pk2(b[2], b[3]); return w; }
__device__ __forceinline__ float dot8(f32x4 a, f32x4 b) { return (a[0] * a[0] + a[1] * a[1]) + (a[2] * a[2] + a[3] * a[3]) + (b[0] * b[0] + b[1] * b[1]) + (b[2] * b[2] + b[3] * b[3]); }
__device__ __forceinline__ float red_fq(float s) { s += __shfl_xor(s, 16); s += __shfl_xor(s, 32); return s; }

struct EpiPlain {
    bf16_t* O; int ldc;
    __device__ __forceinline__ void operator()(AccRef acc, const Unit& u, int wr, int wc, int fr, int fq) const {
        const int row0 = u.pm * 256 + wr * 64 + fr, col0 = u.pn * 256 + wc * 32 + 8 * fq;
        EPI_ROWS(
            _Pragma("unroll") for (int bj = 0; bj < 2; ++bj) *(u32x4*)(O + (size_t)row * ldc + col0 + bj * 128) = pack8(acc[ai][bj][m][0], acc[ai][bj][m][1]);
        )
    }
};
struct EpiSwiglu {
    bf16_t* H; const float* ss;
    __device__ __forceinline__ void operator()(AccRef acc, const Unit& u, int wr, int wc, int fr, int fq) const {
        const int row0 = u.pm * 256 + wr * 64 + fr, col0 = u.pn * 128 + wc * 32 + 8 * fq;
        EPI_ROWS(
            const float rs = __builtin_amdgcn_rsqf(ss[row] * (1.f / 1024.f) + EPS);
            f32x4 o[2];
            _Pragma("unroll") for (int n = 0; n < 2; ++n) _Pragma("unroll") for (int i = 0; i < 4; ++i) { const float gg = acc[ai][0][m][n][i] * rs, uu = acc[ai][1][m][n][i] * rs; o[n][i] = gg * sigmoidf_(gg) * uu; }
            *(u32x4*)(H + (size_t)row * DFF + col0) = pack8(o[0], o[1]);
        )
    }
};
template <bool WB> struct EpiResid {
    const float* res0; const float* res1; float* out; bf16_t* ob; float* ss; float scale;
    __device__ __forceinline__ void operator()(AccRef acc, const Unit& u, int wr, int wc, int fr, int fq) const {
        const int row0 = u.pm * 256 + wr * 64 + fr, col0 = u.pn * 256 + wc * 32 + 8 * fq;
        EPI_ROWS(
            const float* rp = (row < MP) ? res0 + (size_t)row * DM : res1 + (size_t)(row - MP) * DM;
            float s = 0.f;
            _Pragma("unroll") for (int bj = 0; bj < 2; ++bj) { const int col = col0 + bj * 128;
                f32x4 v0 = *(const f32x4*)(rp + col) + acc[ai][bj][m][0] * scale, v1 = *(const f32x4*)(rp + col + 4) + acc[ai][bj][m][1] * scale;
                *(f32x4*)(out + (size_t)row * DM + col) = v0; *(f32x4*)(out + (size_t)row * DM + col + 4) = v1;
                if (WB) *(u32x4*)(ob + (size_t)row * DM + col) = pack8(v0, v1);
                s += dot8(v0, v1); }
            s = red_fq(s); if (fq == 0) unsafeAtomicAdd(ss + row, s);
        )
    }
};
__device__ __forceinline__ float gelu_tanh(float x) { const float y = 1.5957691216057308f * (x + 0.044715f * x * x * x); return x * sigmoidf_(y); }
struct EpiWin {
    const float* ss1; bf16_t* ZA; bf16_t* ZRX; bf16_t* ZRG; unsigned char* ZG8; float* ssq; float* sskv;
    __device__ __forceinline__ void operator()(AccRef acc, const Unit& u, int wr, int wc, int fr, int fq) const {
        const int row0 = u.pm * 256 + wr * 64 + fr, cw = wc * 32 + 8 * fq; const int pn = u.pn;
        EPI_ROWS(
            const float rs = __builtin_amdgcn_rsqf(ss1[row] * (1.f / 1024.f) + EPS);
            f32x4 v[2][2];
            _Pragma("unroll") for (int bj = 0; bj < 2; ++bj) { v[bj][0] = acc[ai][bj][m][0] * rs; v[bj][1] = acc[ai][bj][m][1] * rs; }
            if (pn < 3) {
                _Pragma("unroll") for (int bj = 0; bj < 2; ++bj) *(u32x4*)(ZA + (size_t)row * 768 + pn * 256 + bj * 128 + cw) = pack8(v[bj][0], v[bj][1]);
                float s = dot8(v[0][0], v[0][1]); if (pn != 1) s += dot8(v[1][0], v[1][1]);
                s = red_fq(s); if (fq == 0) unsafeAtomicAdd((pn == 2 ? sskv : ssq) + row, s);
            } else if (pn < 7) {
                _Pragma("unroll") for (int bj = 0; bj < 2; ++bj) *(u32x4*)(ZRX + (size_t)row * 1024 + (pn - 3) * 256 + bj * 128 + cw) = pack8(v[bj][0], v[bj][1]);
            } else if (pn < 11) {
                _Pragma("unroll") for (int bj = 0; bj < 2; ++bj) { _Pragma("unroll") for (int n = 0; n < 2; ++n) _Pragma("unroll") for (int i = 0; i < 4; ++i) v[bj][n][i] = gelu_tanh(v[bj][n][i]);
                    *(u32x4*)(ZRG + (size_t)row * 1024 + (pn - 7) * 256 + bj * 128 + cw) = pack8(v[bj][0], v[bj][1]); }
            } else {
                _Pragma("unroll") for (int bj = 0; bj < 2; ++bj) { unsigned w[2];
                    _Pragma("unroll") for (int n = 0; n < 2; ++n) { unsigned q = 0; _Pragma("unroll") for (int i = 0; i < 4; ++i) { const unsigned b = (unsigned)(sigmoidf_(v[bj][n][i]) * 255.f + 0.5f); q |= (b > 255u ? 255u : b) << (8 * i); } w[n] = q; }
                    *(u32x2*)(ZG8 + (size_t)row * 2048 + (pn - 11) * 256 + bj * 128 + cw) = (u32x2){w[0], w[1]}; }
            }
        )
    }
};
__device__ __forceinline__ int row_pos(int row) { return row < MP ? (row & (SEQ - 1)) : PAST + ((row - MP) & 63); }
struct EpiQ {
    const float* ssq; const f32x2* cs; bf16_t* Q;
    __device__ __forceinline__ void operator()(AccRef acc, const Unit& u, int wr, int wc, int fr, int fq) const {
        const int row0 = u.pm * 256 + wr * 64 + fr;
        EPI_ROWS(
            const float rs = __builtin_amdgcn_rsqf(ssq[row] * (1.f / 384.f) + EPS) * QSCALE; const int pos = row_pos(row);
            _Pragma("unroll") for (int bj = 0; bj < 2; ++bj) { const int G = u.pn * 8 + bj * 4 + wc, h = G / 3, part = G - 3 * h;
                f32x4 v0 = acc[ai][bj][m][0] * rs, v1 = acc[ai][bj][m][1] * rs; bf16_t* qp = Q + (size_t)row * 768 + h * 96;
                if (part < 2) *(u32x4*)(qp + part * 32 + 8 * fq) = pack8(v0, v1);
                else { const f32x2* c = cs + (size_t)pos * 16 + 4 * fq; f32x4 o1, o2;
                    _Pragma("unroll") for (int i = 0; i < 4; ++i) { const f32x2 t = c[i]; o1[i] = v0[i] * t.x - v1[i] * t.y; o2[i] = v1[i] * t.x + v0[i] * t.y; }
                    *(u32x2*)(qp + 64 + 4 * fq) = (u32x2){pk2(o1[0], o1[1]), pk2(o1[2], o1[3])}; *(u32x2*)(qp + 80 + 4 * fq) = (u32x2){pk2(o2[0], o2[1]), pk2(o2[2], o2[3])}; } }
        )
    }
};
struct EpiGates {
    const bf16_t* XC; const float* br; const float* bi; const float* sp; bf16_t* AL; bf16_t* BT;
    __device__ __forceinline__ void operator()(AccRef acc, const Unit& u, int wr, int wc, int fr, int fq) const {
        const int row0 = u.pm * 256 + wr * 64 + fr, ch0 = u.pn * 128 + wc * 32 + 8 * fq;
        EPI_ROWS(
            const bool reset = (row < MP) && ((row & (SEQ - 1)) == 0);
            const u32x4 xw = *(const u32x4*)(XC + (size_t)row * 1024 + ch0);
            u32x4 lw, bw;
            _Pragma("unroll") for (int n = 0; n < 2; ++n) {
                const float* brp = br; const float* bip = bi; const float* spp = sp; asm volatile("" : "+s"(brp), "+s"(bip), "+s"(spp));
                const f32x4 vbr = *(const f32x4*)(brp + ch0 + 4 * n), vbi = *(const f32x4*)(bip + ch0 + 4 * n), vsp = *(const f32x4*)(spp + ch0 + 4 * n);
                f32x4 la, bb;
                _Pragma("unroll") for (int i = 0; i < 4; ++i) {
                    const unsigned w = xw[n * 2 + (i >> 1)]; const float xc = (i & 1) ? bfhi(w) : bflo(w);
                    const float rg = sigmoidf_(acc[ai][0][m][n][i] + vbr[i]), ig = sigmoidf_(acc[ai][1][m][n][i] + vbi[i]);
                    float l = -rg * vsp[i]; l = __uint_as_float((pk2(l, l)) << 16);
                    const float a = __builtin_amdgcn_exp2f(l); float mult = __builtin_amdgcn_sqrtf(fmaxf(1.f - a * a, 0.f));
                    if (reset) { l = -1e30f; mult = 1.f; }
                    la[i] = l; bb[i] = mult * ig * xc; }
                lw[2 * n] = pk2(la[0], la[1]); lw[2 * n + 1] = pk2(la[2], la[3]); bw[2 * n] = pk2(bb[0], bb[1]); bw[2 * n + 1] = pk2(bb[2], bb[3]); }
            *(u32x4*)(AL + (size_t)row * 1024 + ch0) = lw; *(u32x4*)(BT + (size_t)row * 1024 + ch0) = bw;
        )
    }
};
template <int WHICH> struct EpiMerge {
    const unsigned char* ZG8; bf16_t* M1; bf16_t* MB;
    __device__ __forceinline__ void operator()(AccRef acc, const Unit& u, int wr, int wc, int fr, int fq) const {
        const int row0 = u.pm * 256 + wr * 64 + fr, col0 = u.pn * 256 + wc * 32 + 8 * fq;
        EPI_ROWS(
            _Pragma("unroll") for (int bj = 0; bj < 2; ++bj) { const int col = col0 + bj * 128;
                const u32x2 gw = *(const u32x2*)(ZG8 + (size_t)row * 2048 + WHICH * 1024 + col);
                f32x4 v[2];
                _Pragma("unroll") for (int n = 0; n < 2; ++n) _Pragma("unroll") for (int i = 0; i < 4; ++i) v[n][i] = acc[ai][bj][m][n][i] * ((float)((gw[n] >> (8 * i)) & 255u) * (1.f / 255.f));
                if (WHICH == 0) *(u32x4*)(M1 + (size_t)row * 1024 + col) = pack8(v[0], v[1]);
                else { const u32x4 mw = *(const u32x4*)(M1 + (size_t)row * 1024 + col);
                    _Pragma("unroll") for (int n = 0; n < 2; ++n) { v[n][0] += bflo(mw[2 * n]); v[n][1] += bfhi(mw[2 * n]); v[n][2] += bflo(mw[2 * n + 1]); v[n][3] += bfhi(mw[2 * n + 1]); }
                    *(u32x4*)(MB + (size_t)row * 1024 + col) = pack8(v[0], v[1]); } }
        )
    }
};


constexpr size_t WS_BAR = 1 * MiB - 16384;
constexpr size_t WS_CNT = WS_BAR + 14336;
#define XB_TMO      128
#define XB_XCNT(j)  (256  + 64 * (j))
#define XB_XSUB(j)  (1280 + 64 * (j))
#define XB_XGEN(j)  (2304 + 64 * (j))
#define XB_TOP      3328
#define XB_TOPGEN   3392
#define XCD_BAR_WORDS 3456
#define XB_SPIN_CAP (1u << 24)
__device__ __forceinline__ unsigned xb_ld(unsigned* p)              { return __hip_atomic_load(p, __ATOMIC_RELAXED, __HIP_MEMORY_SCOPE_AGENT); }
__device__ __forceinline__ unsigned xb_add(unsigned* p, unsigned v) { return __hip_atomic_fetch_add(p, v, __ATOMIC_RELAXED, __HIP_MEMORY_SCOPE_AGENT); }
__device__ __forceinline__ unsigned xb_xcc_id() { return (unsigned)__builtin_amdgcn_s_getreg((3 << 11) | 20) & 0xFu; }
#define XB_SPIN(cond, bar) do { unsigned _sp = 0; while (cond) { __builtin_amdgcn_s_sleep(1); \
    if ((++_sp & 255u) == 0u) { if (xb_ld(&(bar)[XB_TMO])) break; if (_sp > XB_SPIN_CAP) { atomicAdd(&(bar)[XB_TMO], 1u); break; } } } } while (0)
struct XcdBarrier { unsigned* bar; unsigned x; volatile LAS unsigned* st; };
__device__ __forceinline__ XcdBarrier xcd_barrier_post(unsigned* bar, volatile LAS unsigned* st) {
    XcdBarrier b; b.bar = bar; b.x = xb_xcc_id(); b.st = st;
    if (threadIdx.x == 0) (void)xb_add(&bar[XB_XCNT(b.x)], 1u);
    return b;
}
__device__ __forceinline__ void xcd_barrier_complete(unsigned* bar, unsigned x, unsigned& nloc, unsigned& nx) {
    const unsigned G = gridDim.x * gridDim.y * gridDim.z;
    unsigned sum, cnt, mine, sp = 0u;
    for (;;) {
        sum = 0u; cnt = 0u; mine = 0u;
#pragma unroll
        for (unsigned j = 0; j < 16; ++j) { const unsigned c = xb_ld(&bar[XB_XCNT(j)]); sum += c; cnt += (c > 0u) ? 1u : 0u; mine = (j == x) ? c : mine; }
        if (sum == G) break;
        __builtin_amdgcn_s_sleep(1);
        if ((++sp & 255u) == 0u) { if (xb_ld(&bar[XB_TMO])) break; if (sp > XB_SPIN_CAP) { atomicAdd(&bar[XB_TMO], 1u); break; } }
    }
    nloc = mine > 0u ? mine : 1u; nx = cnt > 0u ? cnt : 1u;
}
__device__ __forceinline__ void xcd_barrier(const XcdBarrier& b) {
    asm volatile("s_waitcnt vmcnt(0)" ::: "memory");
    __syncthreads();
    if (threadIdx.x == 0) {
        unsigned* bar = b.bar;
        __builtin_amdgcn_s_waitcnt(0);
        unsigned nloc = b.st[0], nx = b.st[1];
        if (nloc == 0u) { xcd_barrier_complete(bar, b.x, nloc, nx); b.st[0] = nloc; b.st[1] = nx; }
        const unsigned old = xb_add(&bar[XB_XSUB(b.x)], 1u);
        const unsigned gen = old / nloc;
        if (old + 1u == (gen + 1u) * nloc) {
            __builtin_amdgcn_fence(__ATOMIC_RELEASE, "agent");
            asm volatile("s_waitcnt vmcnt(0)" ::: "memory");
            const unsigned og = xb_add(&bar[XB_TOP], 1u);
            const unsigned tg = og / nx;
            if (og + 1u == (tg + 1u) * nx) xb_add(&bar[XB_TOPGEN], 1u);
            else XB_SPIN(xb_ld(&bar[XB_TOPGEN]) == tg, bar);
            __builtin_amdgcn_fence(__ATOMIC_ACQUIRE, "agent");
            xb_add(&bar[XB_XGEN(b.x)], 1u);
            asm volatile("s_waitcnt vmcnt(0)" ::: "memory");
        } else {
            XB_SPIN(xb_ld(&bar[XB_XGEN(b.x)]) == gen, bar);
            __builtin_amdgcn_fence(__ATOMIC_ACQUIRE, "agent");
            asm volatile("s_waitcnt vmcnt(0)" ::: "memory");
        }
    }
    __syncthreads();
}

struct Args { const float* in[31]; float* out; unsigned char* ws; int ph_lo, ph_hi; };
struct Ctx { const float* const* in; float* out; unsigned char* ws; LAS unsigned char* lds; int tid, lane, wave, G, bx, vcu; };

__device__ __forceinline__ void tr_item(const float* __restrict__ W, int ldw, const float* __restrict__ gain, bf16_t* WT, int ldt, int k0, int n0, int drow0, bool rperm, LAS float* scr, int lane) {
    float tv[32];
#pragma unroll
    for (int i = 0; i < 32; ++i) { const int kk = 2 * i + (lane >> 5); tv[i] = W[(size_t)(k0 + kk) * ldw + n0 + (lane & 31)]; }
    if (gain) {
#pragma unroll
        for (int i = 0; i < 32; ++i) tv[i] *= gain[k0 + 2 * i + (lane >> 5)]; }
#pragma unroll
    for (int i = 0; i < 32; ++i) scr[(2 * i + (lane >> 5)) * 33 + (lane & 31)] = tv[i];
    asm volatile("s_waitcnt lgkmcnt(0)" ::: "memory");
    const int c = lane & 7;
#pragma unroll
    for (int j = 0; j < 4; ++j) { const int n = (lane >> 3) + 8 * j; const LAS float* s = scr + (8 * c) * 33 + n;
        u32x4 o; o.x = pk2(s[0 * 33], s[1 * 33]); o.y = pk2(s[2 * 33], s[3 * 33]); o.z = pk2(s[4 * 33], s[5 * 33]); o.w = pk2(s[6 * 33], s[7 * 33]);
        const int dn = rperm ? (8 * ((n & 15) >> 2) + 4 * (n >> 4) + (n & 3)) : n;
        *(u32x4*)(WT + (size_t)(drow0 + dn) * ldt + k0 + 8 * c) = o; }
    asm volatile("s_waitcnt lgkmcnt(0)" ::: "memory");
}
__device__ __forceinline__ int map_row(int kind, int n0, int off) {
    if (kind == 0) return off + n0;
    if (kind == 1) return (n0 >> 7) * 256 + off + (n0 & 127);
    if (kind == 2) return n0 < 384 ? n0 : (n0 < 640 ? 512 + (n0 - 384) : (n0 < 672 ? 384 + (n0 - 640) : 768 + (n0 - 672)));
    if (kind == 3) return n0;
    const int h = n0 >> 7, j = n0 & 127; return (j < 64 ? 0 : 512) + h * 64 + (j & 63);
}
__device__ __forceinline__ void p0_prologue(const Ctx& C) {
    unsigned char* ws = C.ws; const float* const* in = C.in;
    LAS float* scr = (LAS float*)(C.lds + C.wave * 8704);
    const int gw = C.bx * 8 + C.wave, NGW = C.G * 8, gt = C.bx * 512 + C.tid, NGT = C.G * 512;
    { float* st = (float*)(ws + WS_STAT); for (int i = gt; i < 5 * MT; i += NGT) st[i] = 0.f;
      unsigned* wp = (unsigned*)(ws + W_IN + (size_t)416 * 1024 * 2); for (int i = gt; i < 96 * 1024 / 2; i += NGT) wp[i] = 0u; }
    { f32x2* cs = (f32x2*)(ws + WS_CS);
      for (int i = gt; i < SEQ * 16; i += NGT) { const int pos = i >> 4, j = i & 15;
          const double base = (j & 3) == 0 ? 1.0 : ((j & 3) == 1 ? 0.5623413251903491 : ((j & 3) == 2 ? 0.31622776601683794 : 0.17782794100389228));
          const double sc = (j >> 2) == 0 ? 1.0 : ((j >> 2) == 1 ? 0.1 : ((j >> 2) == 2 ? 0.01 : 0.001));
          const double a = (double)pos * (base * sc); const double kq = __builtin_rint(a * 0.6366197723675814); const double r = (a - kq * 1.5707963267948966) - kq * 6.123233995736766e-17;
          const double r2 = r * r;
          const double sn = r * (1.0 + r2 * (-1.0 / 6 + r2 * (1.0 / 120 + r2 * (-1.0 / 5040 + r2 * (1.0 / 362880 + r2 * (-1.0 / 39916800))))));
          const double cn = 1.0 + r2 * (-0.5 + r2 * (1.0 / 24 + r2 * (-1.0 / 720 + r2 * (1.0 / 40320 + r2 * (-1.0 / 3628800 + r2 * (1.0 / 479001600))))));
          const int q = (int)((long long)kq & 3); const double s = (q == 0) ? sn : (q == 1 ? cn : (q == 2 ? -sn : -cn)), c = (q == 0) ? cn : (q == 1 ? -sn : (q == 2 ? -cn : sn));
          cs[i] = (f32x2){(float)c, (float)s}; }
      float* sp = (float*)(ws + WS_SP); const float* lam = in[23];
      for (int i = gt; i < 1024; i += NGT) sp[i] = 8.f * LOG2E * log1pf(expf(-lam[i])); }
    constexpr int I_FF = 16 * 88, I_IN = 16 * 149, I_UQ = 6 * 24, I_KV = 4 * 32, I_OA = 8 * 32, I_SQ = 16 * 32, I_G = 2 * 4 * 8;
    constexpr int NITEMS = 6 * I_FF + I_IN + I_UQ + I_KV + I_OA + 2 * I_SQ + 2 * I_G;
#define TR_MAT(CNT, W_, K_, N_, GAIN_, WT_, LDT_, KIND_, OFF_) if (r < (CNT)) { const int nn_ = (N_) / 32, kb = r / nn_, nb = r % nn_, n0 = nb * 32; \
        tr_item(W_, N_, GAIN_, (bf16_t*)(ws + (WT_)), LDT_, kb * 64, n0, map_row(KIND_, n0, OFF_), (KIND_) == 3 && (n0 % 96 == 64), scr, C.lane); continue; } r -= (CNT);
    for (int it = gw; it < NITEMS; it += NGW) {
        int r = it;
        TR_MAT(I_FF, in[7], 1024, DFF, in[6], W_13A, 1024, 1, 0)
        TR_MAT(I_FF, in[8], 1024, DFF, in[6], W_13A, 1024, 1, 128)
        TR_MAT(I_FF, in[9], DFF, 1024, nullptr, W_2A, DFF, 0, 0)
        TR_MAT(I_FF, in[27], 1024, DFF, in[26], W_13B, 1024, 1, 0)
        TR_MAT(I_FF, in[28], 1024, DFF, in[26], W_13B, 1024, 1, 128)
        TR_MAT(I_FF, in[29], DFF, 1024, nullptr, W_2B, DFF, 0, 0)
        TR_MAT(I_IN, in[11], 1024, 4768, in[10], W_IN, 1024, 2, 0)
        TR_MAT(I_UQ, in[13], 384, 768, in[12], W_UQ, 384, 3, 0)
        TR_MAT(I_KV, in[15], 256, 1024, nullptr, W_KV, 256, 4, 0)
        TR_MAT(I_OA, in[16], 512, 1024, nullptr, W_OA, 512, 0, 0)
        TR_MAT(I_SQ, in[24], 1024, 1024, nullptr, W_OR, 1024, 0, 0)
        TR_MAT(I_SQ, in[25], 1024, 1024, nullptr, W_OUT, 1024, 0, 0)
        if (r < I_G) { const int blk = r >> 3, q = r & 7; tr_item(in[19] + (size_t)blk * 16384, 128, nullptr, (bf16_t*)(ws + W_G), 128, (q >> 2) * 64, (q & 3) * 32, blk * 256 + (q & 3) * 32, false, scr, C.lane); continue; } r -= I_G;
        { const int blk = r >> 3, q = r & 7; tr_item(in[21] + (size_t)blk * 16384, 128, nullptr, (bf16_t*)(ws + W_G), 128, (q >> 2) * 64, (q & 3) * 32, blk * 256 + 128 + (q & 3) * 32, false, scr, C.lane); }
    }
#undef TR_MAT
    { bf16_t* AB = (bf16_t*)(ws + WS_AB); float* ss0 = (float*)(ws + WS_STAT) + 5 * MT;
      for (int row0 = gw * 2; row0 < MT; row0 += NGW * 2) {
          f32x4 v[2][4];
#pragma unroll
          for (int q = 0; q < 2; ++q) { const int row = row0 + q; const float* xr = row < MP ? in[0] + (size_t)row * DM : in[1] + (size_t)(row - MP) * DM;
#pragma unroll
              for (int j = 0; j < 4; ++j) v[q][j] = *(const f32x4*)(xr + 256 * j + 4 * C.lane); }
#pragma unroll
          for (int q = 0; q < 2; ++q) { const int row = row0 + q; float s = 0.f;
#pragma unroll
              for (int j = 0; j < 4; ++j) s += (v[q][j][0] * v[q][j][0] + v[q][j][1] * v[q][j][1]) + (v[q][j][2] * v[q][j][2] + v[q][j][3] * v[q][j][3]);
              s = wave_sum(s); if (C.lane == 0) ss0[row] = s;
#pragma unroll
              for (int j = 0; j < 4; ++j) *(u32x2*)(AB + (size_t)row * DM + 256 * j + 4 * C.lane) = (u32x2){pk2(v[q][j][0], v[q][j][1]), pk2(v[q][j][2], v[q][j][3])}; } } }
    { bf16_t* CKV = (bf16_t*)(ws + WS_CKV); bf16_t* KR = (bf16_t*)(ws + WS_KR);
      for (int r = gw; r < SBATCH * PAST; r += NGW) { const int b = r >> 10, p = r & 1023; const size_t kr = (size_t)MP + b * SKV + p;
          const f32x4 v = *(const f32x4*)(in[2] + (size_t)r * 256 + 4 * C.lane); *(u32x2*)(CKV + kr * 256 + 4 * C.lane) = (u32x2){pk2(v[0], v[1]), pk2(v[2], v[3])};
          if (C.lane < 8) { const f32x4 w = *(const f32x4*)(in[3] + (size_t)r * 32 + 4 * C.lane); *(u32x2*)(KR + kr * 32 + 4 * C.lane) = (u32x2){pk2(w[0], w[1]), pk2(w[2], w[3])}; } } }
}

__device__ __forceinline__ void p4_mid(const Ctx& C) {
    unsigned char* ws = C.ws; const float* const* in = C.in; const int lane = C.lane;
    const bf16_t* ZA = (const bf16_t*)(ws + WS_ZA); const bf16_t* ZRX = (const bf16_t*)(ws + WS_ZRX);
    bf16_t* CKV = (bf16_t*)(ws + WS_CKV); bf16_t* KR = (bf16_t*)(ws + WS_KR); bf16_t* XC = (bf16_t*)(ws + WS_XC);
    const float* sskv = (const float*)(ws + WS_STAT) + 2 * MT; const f32x2* cs = (const f32x2*)(ws + WS_CS);
    const int gw = C.bx * 8 + C.wave, NGW = C.G * 8;
    const f32x4 gkv = *(const f32x4*)(in[14] + 4 * lane);
    for (int row0 = gw * 4; row0 < MT; row0 += NGW * 4) {
        u32x2 zw[4]; float sk[4];
#pragma unroll
        for (int i = 0; i < 4; ++i) { zw[i] = *(const u32x2*)(ZA + (size_t)(row0 + i) * 768 + 512 + 4 * lane); sk[i] = sskv[row0 + i]; }
        { const int rr = row0 + (lane >> 4), j = lane & 15; const bool isP = rr < MP; const int r2 = rr - MP;
          const int b = isP ? (rr >> 14) : (r2 >> 6), t = isP ? (rr & (SEQ - 1)) : (r2 & 63), pos = isP ? t : PAST + t; const size_t krow = isP ? (size_t)rr : (size_t)MP + b * SKV + PAST + t;
          const float x1 = bf1(ZA[(size_t)rr * 768 + 384 + j]), x2 = bf1(ZA[(size_t)rr * 768 + 400 + j]); const f32x2 tcs = cs[(size_t)pos * 16 + j];
          const float o1 = x1 * tcs.x - x2 * tcs.y, o2 = x2 * tcs.x + x1 * tcs.y;
          float* o = isP ? C.out + O_KRP + (size_t)rr * 32 : C.out + O_KRS + (size_t)r2 * 32; o[j] = o1; o[16 + j] = o2;
          KR[krow * 32 + j] = (bf16_t)(pk2(o1, o1) & 0xffffu); KR[krow * 32 + 16 + j] = (bf16_t)(pk2(o2, o2) & 0xffffu); }
#pragma unroll
        for (int i = 0; i < 4; ++i) { const int row = row0 + i; const bool isP = row < MP; const int r2 = row - MP;
            const int b = isP ? (row >> 14) : (r2 >> 6), t = isP ? (row & (SEQ - 1)) : (r2 & 63); const size_t krow = isP ? (size_t)row : (size_t)MP + b * SKV + PAST + t;
            const float rk = __builtin_amdgcn_rsqf(sk[i] * (1.f / 256.f) + EPS);
            f32x4 c = {bflo(zw[i].x) * rk * gkv[0], bfhi(zw[i].x) * rk * gkv[1], bflo(zw[i].y) * rk * gkv[2], bfhi(zw[i].y) * rk * gkv[3]};
            float* o = isP ? C.out + O_KVP + (size_t)row * 256 : C.out + O_KVS + (size_t)r2 * 256; *(f32x4*)(o + 4 * lane) = c;
            *(u32x2*)(CKV + krow * 256 + 4 * lane) = (u32x2){pk2(c[0], c[1]), pk2(c[2], c[3])}; }
    }
    for (int it = gw; it < (MT / 16) * 4; it += NGW) {
        const int r0 = (it >> 2) * 16, ch = 256 * (it & 3) + 4 * lane; const bool isP = r0 < MP; const int r2 = r0 - MP;
        const int b = isP ? (r0 >> 14) : (r2 >> 6), t0 = isP ? (r0 & (SEQ - 1)) : (r2 & 63), S = isP ? SEQ : SSEQ;
        u32x2 xw[19];
#pragma unroll
        for (int i = 0; i < 16; ++i) xw[3 + i] = *(const u32x2*)(ZRX + (size_t)(r0 + i) * 1024 + ch);
        if (t0 > 0) {
#pragma unroll
            for (int i = 0; i < 3; ++i) xw[i] = *(const u32x2*)(ZRX + (size_t)(r0 - 3 + i) * 1024 + ch);
        } else if (!isP) {
#pragma unroll
            for (int i = 0; i < 3; ++i) { const f32x4 sv = *(const f32x4*)(in[4] + ((size_t)b * 3 + i) * 1024 + ch); xw[i] = (u32x2){pk2(sv[0], sv[1]), pk2(sv[2], sv[3])}; }
        } else {
#pragma unroll
            for (int i = 0; i < 3; ++i) xw[i] = (u32x2){0u, 0u};
        }
        const f32x4 cb = *(const f32x4*)(in[18] + ch), w0 = *(const f32x4*)(in[17] + ch), w1 = *(const f32x4*)(in[17] + 1024 + ch), w2 = *(const f32x4*)(in[17] + 2048 + ch), w3 = *(const f32x4*)(in[17] + 3072 + ch);
#define UNP(w) ((f32x4){bflo((w).x), bfhi((w).x), bflo((w).y), bfhi((w).y)})
#pragma unroll
        for (int i = 0; i < 16; ++i) { const f32x4 a = cb + UNP(xw[i]) * w0 + UNP(xw[i + 1]) * w1 + UNP(xw[i + 2]) * w2 + UNP(xw[i + 3]) * w3;
            *(u32x2*)(XC + (size_t)(r0 + i) * 1024 + ch) = (u32x2){pk2(a[0], a[1]), pk2(a[2], a[3])}; }
        if (t0 + 16 == S) { float* o = (isP ? C.out + O_CVP : C.out + O_CVS) + (size_t)b * 3 * 1024 + ch;
#pragma unroll
            for (int i = 0; i < 3; ++i) *(f32x4*)(o + (size_t)i * 1024) = UNP(xw[16 + i]); }
#undef UNP
    }
}

__device__ __forceinline__ f32x4 ld_bf4(const bf16_t* p) { const u32x2 w = *(const u32x2*)p; return (f32x4){bflo(w.x), bfhi(w.x), bflo(w.y), bfhi(w.y)}; }
__device__ __forceinline__ f32x4 exp2v(f32x4 v) { return (f32x4){__builtin_amdgcn_exp2f(v[0]), __builtin_amdgcn_exp2f(v[1]), __builtin_amdgcn_exp2f(v[2]), __builtin_amdgcn_exp2f(v[3])}; }
__device__ __forceinline__ void p6_scan1(const Ctx& C) {
    const bf16_t* AL = (const bf16_t*)(C.ws + WS_AB); const bf16_t* BT = (const bf16_t*)(C.ws + WS_ZRX); float* SA = (float*)(C.ws + WS_SA); float* SB = (float*)(C.ws + WS_SB);
    for (int u = C.bx; u < 256; u += C.G) { const int chunk = 2 * u + (C.tid >> 8), c4 = (C.tid & 255) * 4; const size_t base = (size_t)chunk * 64 * 1024 + c4;
        f32x4 A = {1.f, 1.f, 1.f, 1.f}, B = {0.f, 0.f, 0.f, 0.f};
#pragma unroll 8
        for (int r = 0; r < 64; ++r) { const f32x4 a = exp2v(ld_bf4(AL + base + (size_t)r * 1024)), b = ld_bf4(BT + base + (size_t)r * 1024); B = a * B + b; A = A * a; }
        *(f32x4*)(SA + (size_t)chunk * 1024 + c4) = A; *(f32x4*)(SB + (size_t)chunk * 1024 + c4) = B; }
}
__device__ __forceinline__ void p7_scan3(const Ctx& C) {
    const bf16_t* AL = (const bf16_t*)(C.ws + WS_AB); const bf16_t* BT = (const bf16_t*)(C.ws + WS_ZRX); const bf16_t* ZRG = (const bf16_t*)(C.ws + WS_ZRG);
    const float* SA = (const float*)(C.ws + WS_SA); const float* SB = (const float*)(C.ws + WS_SB); bf16_t* HG = (bf16_t*)(C.ws + WS_XC);
    for (int u = C.bx; u < 260; u += C.G) {
        f32x4 h; size_t base; int nchunkpre = 0, cb = 0, c4; float* hout = nullptr;
        if (u < 256) { const int chunk = 2 * u + (C.tid >> 8); c4 = (C.tid & 255) * 4; base = (size_t)chunk * 64 * 1024 + c4; nchunkpre = chunk & 255; cb = chunk - nchunkpre; h = (f32x4){0.f, 0.f, 0.f, 0.f};
            if (nchunkpre == 255) hout = C.out + O_HP + (size_t)(chunk >> 8) * 1024 + c4; }
        else { const int idx = (u - 256) * 512 + C.tid, b = idx >> 8; c4 = (idx & 255) * 4; base = ((size_t)MP + b * 64) * 1024 + c4; h = *(const f32x4*)(C.in[5] + (size_t)b * 1024 + c4); hout = C.out + O_HS + (size_t)b * 1024 + c4; }
#pragma unroll 16
        for (int c = 0; c < nchunkpre; ++c) { const f32x4 a = *(const f32x4*)(SA + (size_t)(cb + c) * 1024 + c4), b = *(const f32x4*)(SB + (size_t)(cb + c) * 1024 + c4); h = a * h + b; }
#pragma unroll 8
        for (int r = 0; r < 64; ++r) { const f32x4 a = exp2v(ld_bf4(AL + base + (size_t)r * 1024)), b = ld_bf4(BT + base + (size_t)r * 1024), g = ld_bf4(ZRG + base + (size_t)r * 1024);
            h = a * h + b; const f32x4 o = h * g; *(u32x2*)(HG + base + (size_t)r * 1024) = (u32x2){pk2(o[0], o[1]), pk2(o[2], o[3])}; }
        if (hout) *(f32x4*)hout = h;
    }
}

constexpr int KT_STRIDE = 208, KT_BYTES = 64 * KT_STRIDE, VT_STRIDE = 144, VT_BYTES = 64 * VT_STRIDE;
constexpr int AT_K0 = 0, AT_V0 = 2 * KT_BYTES;
#define SBAR() __builtin_amdgcn_sched_barrier(0)
#define AT_X(P0, P1, i) ((i) < 16 ? P0[(i) & 15] : P1[(i) & 15])
#define AT_MFMA __builtin_amdgcn_mfma_f32_32x32x16_bf16
template <bool FIRST>
__device__ __forceinline__ void at_step(f32x16& o0, f32x16& o1, f32x16& negm, float& mrun, float& lrun, const bf16x8 (&qr)[6], const LAS unsigned char* Kb, const LAS unsigned char* Vb) {
    f32x16 C0, C1;
    {   bf16x8 ka = *(const LAS bf16x8*)(Kb);
#define AT_GA(g) { bf16x8 na = ka; if ((g) < 5) na = *(const LAS bf16x8*)(Kb + ((g) + 1) * 32); else na = *(const LAS bf16x8*)(Kb + 32 * KT_STRIDE); \
        if ((g) == 0) C0 = AT_MFMA(ka, qr[0], negm, 0, 0, 0); else C0 = AT_MFMA(ka, qr[g], C0, 0, 0, 0); ka = na; }
        AT_GA(0) AT_GA(1) AT_GA(2) AT_GA(3) AT_GA(4) AT_GA(5)
#undef AT_GA
#define AT_GA(g) { bf16x8 na = ka; if ((g) < 5) na = *(const LAS bf16x8*)(Kb + 32 * KT_STRIDE + ((g) + 1) * 32); \
        if ((g) == 0) C1 = AT_MFMA(ka, qr[0], negm, 0, 0, 0); else C1 = AT_MFMA(ka, qr[g], C1, 0, 0, 0); ka = na; }
        AT_GA(0) AT_GA(1) AT_GA(2) AT_GA(3) AT_GA(4) AT_GA(5)
#undef AT_GA
    }
    bf16x8 va = *(const LAS bf16x8*)(Vb), vb = *(const LAS bf16x8*)(Vb + 32 * VT_STRIDE);
    float sacc = 0.f;
#define AT_GB(s4, CC, j) { bf16x8 na = va, nb = vb; if ((s4) < 3) { na = *(const LAS bf16x8*)(Vb + ((s4) + 1) * 32); nb = *(const LAS bf16x8*)(Vb + 32 * VT_STRIDE + ((s4) + 1) * 32); } \
    const float e0 = __builtin_amdgcn_exp2f(CC[(j)]), e1 = __builtin_amdgcn_exp2f(CC[(j) + 1]), e2 = __builtin_amdgcn_exp2f(CC[(j) + 2]), e3 = __builtin_amdgcn_exp2f(CC[(j) + 3]); \
    const float e4 = __builtin_amdgcn_exp2f(CC[(j) + 4]), e5 = __builtin_amdgcn_exp2f(CC[(j) + 5]), e6 = __builtin_amdgcn_exp2f(CC[(j) + 6]), e7 = __builtin_amdgcn_exp2f(CC[(j) + 7]); \
    sacc += ((e0 + e1) + (e2 + e3)) + ((e4 + e5) + (e6 + e7)); \
    const u32x4 w = {pk2(e0, e1), pk2(e2, e3), pk2(e4, e5), pk2(e6, e7)}; const bf16x8 pb = __builtin_bit_cast(bf16x8, w); \
    o0 = AT_MFMA(va, pb, o0, 0, 0, 0); o1 = AT_MFMA(vb, pb, o1, 0, 0, 0); va = na; vb = nb; }
    {   float rm = fmaxf(fmaxf(C0[0], C0[1]), C0[2]);
#pragma unroll
        for (int r = 3; r < 15; r += 2) rm = fmaxf(fmaxf(rm, C0[r]), C0[r + 1]);
        rm = fmaxf(rm, C0[15]);
        rm = fmaxf(rm, __shfl_xor(rm, 32));
        if (FIRST) { const float dl = rm; mrun = dl;
#pragma unroll
            for (int r = 0; r < 16; ++r) { C0[r] -= dl; C1[r] -= dl; negm[r] = -mrun; }
            asm volatile("" : "+v"(negm));
        } else if (__builtin_expect(__any(rm > 8.f), 0)) { const float dl = fmaxf(rm, 0.f); mrun += dl;
#pragma unroll
            for (int r = 0; r < 16; ++r) { C0[r] -= dl; C1[r] -= dl; negm[r] = -mrun; }
            asm volatile("" : "+v"(negm));
            const float f = __builtin_amdgcn_exp2f(-dl); lrun *= f;
#pragma unroll
            for (int r = 0; r < 16; ++r) { o0[r] *= f; o1[r] *= f; } }
    }
    AT_GB(0, C0, 0) AT_GB(1, C0, 8)
    lrun += sacc; sacc = 0.f;
    {   float rm = fmaxf(fmaxf(C1[0], C1[1]), C1[2]);
#pragma unroll
        for (int r = 3; r < 15; r += 2) rm = fmaxf(fmaxf(rm, C1[r]), C1[r + 1]);
        rm = fmaxf(rm, C1[15]);
        rm = fmaxf(rm, __shfl_xor(rm, 32));
        if (__builtin_expect(__any(rm > 8.f), 0)) { const float dl = fmaxf(rm, 0.f); mrun += dl;
#pragma unroll
            for (int r = 0; r < 16; ++r) { C1[r] -= dl; negm[r] = -mrun; }
            asm volatile("" : "+v"(negm));
            const float f = __builtin_amdgcn_exp2f(-dl); lrun *= f;
#pragma unroll
            for (int r = 0; r < 16; ++r) { o0[r] *= f; o1[r] *= f; } }
    }
    AT_GB(2, C1, 0) AT_GB(3, C1, 8)
#undef AT_GB
    lrun += sacc;
}
__device__ __forceinline__ void attn_unit(const Ctx& C, int qrow0, int krow0, int h, int NT, int ntw) {
    const bf16_t* Q = (const bf16_t*)(C.ws + WS_ZRX); const bf16_t* KN = (const bf16_t*)(C.ws + WS_ZRG); const bf16_t* KRp = (const bf16_t*)(C.ws + WS_KR);
    const bf16_t* VT = (const bf16_t*)(C.ws + WS_AB); bf16_t* O = (bf16_t*)(C.ws + WS_ZA);
    int tid_ = threadIdx.x; asm volatile("" : "+v"(tid_));
    const int tid = tid_, lane = tid & 63, wid = __builtin_amdgcn_readfirstlane(tid >> 6), r32 = lane & 31, hi = lane >> 5;
    LAS unsigned char* lds = C.lds;
    bf16x8 qr[6];
    if (ntw > 0) {
#pragma unroll
        for (int ds = 0; ds < 6; ++ds) qr[ds] = *(const bf16x8*)(Q + (size_t)(qrow0 + wid * 32 + r32) * 768 + h * 96 + ds * 16 + hi * 8);
    } else {
#pragma unroll
        for (int ds = 0; ds < 6; ++ds) qr[ds] = (bf16x8){0, 0, 0, 0, 0, 0, 0, 0};
    }
    const bf16_t* ksrc = KN + (size_t)(krow0 + (tid >> 3)) * 512 + h * 64 + (tid & 7) * 8;
    const bf16_t* rsrc = KRp + (size_t)(krow0 + ((tid & 255) >> 2)) * 32 + (tid & 3) * 8;
    const bf16_t* vsrc = VT + (size_t)(h * 64 + (tid >> 3)) * KVROWS + krow0 + (tid & 7) * 8;
    const int kdst = (tid >> 3) * KT_STRIDE + (tid & 7) * 16, rdst = ((tid & 255) >> 2) * KT_STRIDE + 128 + (tid & 3) * 16;
    const int vdst = AT_V0 + (tid >> 3) * VT_STRIDE + (((tid & 7) >> 1) * 16 + 4 * (tid & 1)) * 2;
    u32x4 kA, rA, vA, kB, rB, vB;
#define AT_LOAD(t, K_, R_, V_) do { K_ = *(const u32x4*)(ksrc + (size_t)(t) * 64 * 512); if (tid < 256) R_ = *(const u32x4*)(rsrc + (size_t)(t) * 64 * 32); V_ = *(const u32x4*)(vsrc + (size_t)(t) * 64); } while (0)
#define AT_STORE(t, K_, R_, V_) do { LAS unsigned char* sk = lds + AT_K0 + ((t) & 1) * KT_BYTES; *(LAS u32x4*)(sk + kdst) = K_; if (tid < 256) *(LAS u32x4*)(sk + rdst) = R_; \
        LAS unsigned char* sv = lds + ((t) & 1) * VT_BYTES; *(LAS u32x2*)(sv + vdst) = (u32x2){V_.x, V_.y}; *(LAS u32x2*)(sv + vdst + 16) = (u32x2){V_.z, V_.w}; } while (0)
#define AT_BAR() asm volatile("s_waitcnt lgkmcnt(0)\n\ts_barrier" ::: "memory")
    f32x16 o0 = {}, o1 = {}, negm = {}; float mrun = 0.f, lrun = 0.f;
    asm volatile("" : "+v"(negm));
    if (wid >= 4) __builtin_amdgcn_s_setprio(1);
    const LAS unsigned char* Kl = lds + AT_K0 + r32 * KT_STRIDE + hi * 16; const LAS unsigned char* Vl = lds + AT_V0 + r32 * VT_STRIDE + hi * 16;
    AT_LOAD(0, kA, rA, vA); if (NT > 1) AT_LOAD(1, kB, rB, vB);
    AT_STORE(0, kA, rA, vA);
    AT_BAR();
    if (NT > 2) AT_LOAD(2, kA, rA, vA);
    if (ntw > 0) at_step<true>(o0, o1, negm, mrun, lrun, qr, Kl, Vl);
    if (NT > 1) AT_STORE(1, kB, rB, vB);
    AT_BAR();
    int t = 1;
#pragma nounroll
    for (; t + 1 < NT; t += 2) {
        if (t + 2 < NT) AT_LOAD(t + 2, kB, rB, vB);
        if (t < ntw) at_step<false>(o0, o1, negm, mrun, lrun, qr, Kl + KT_BYTES, Vl + VT_BYTES);
        AT_STORE(t + 1, kA, rA, vA);
        AT_BAR();
        if (t + 3 < NT) AT_LOAD(t + 3, kA, rA, vA);
        if (t + 1 < ntw) at_step<false>(o0, o1, negm, mrun, lrun, qr, Kl, Vl);
        if (t + 2 < NT) AT_STORE(t + 2, kB, rB, vB);
        AT_BAR();
    }
    if (t < NT) {
        if (t < ntw) at_step<false>(o0, o1, negm, mrun, lrun, qr, Kl + KT_BYTES, Vl + VT_BYTES);
        AT_BAR();
    }
#undef AT_LOAD
#undef AT_STORE
#undef AT_BAR
    __builtin_amdgcn_s_setprio(0);
    if (ntw > 0) {
        const float lt = lrun + __shfl_xor(lrun, 32), inv = 1.f / lt;
        bf16_t* op = O + (size_t)(qrow0 + wid * 32 + r32) * 512 + h * 64 + 4 * hi;
#pragma unroll
        for (int g = 0; g < 4; ++g) {
            *(u32x2*)(op + 8 * g) = (u32x2){pk2(o0[4 * g] * inv, o0[4 * g + 1] * inv), pk2(o0[4 * g + 2] * inv, o0[4 * g + 3] * inv)};
            *(u32x2*)(op + 32 + 8 * g) = (u32x2){pk2(o1[4 * g] * inv, o1[4 * g + 1] * inv), pk2(o1[4 * g + 2] * inv, o1[4 * g + 3] * inv)}; }
    }
}
__device__ __forceinline__ void p9_attn(const Ctx& C) {
    for (int k = C.vcu; k < 576; k += C.G) {
        if (k < 512) { const int bh = k >> 5, j = k & 31, b = bh >> 3, h = bh & 7;
#pragma unroll 1
            for (int e = 0; e < 2; ++e) { const int qb = e == 0 ? 63 - j : j; attn_unit(C, b * SEQ + 256 * qb, b * SEQ, h, 4 * qb + 4, 4 * qb + (C.wave >> 1) + 1); } }
        else { const int s = k - 512, bs = s >> 3, h = s & 7; attn_unit(C, MP + bs * 64, MP + bs * SKV, h, 17, C.wave < 2 ? 17 : 0); }
    }
}
__device__ __forceinline__ void p14_final(const Ctx& C) {
    const float* ss3 = (const float*)(C.ws + WS_STAT) + 4 * MT; const float* gf = C.in[30];
    const int gw = C.bx * 8 + C.wave, NGW = C.G * 8;
    for (int row0 = gw * 2; row0 < MT; row0 += NGW * 2) {
        f32x4 v[2][4]; float rs[2];
#pragma unroll
        for (int q = 0; q < 2; ++q) { rs[q] = __builtin_amdgcn_rsqf(ss3[row0 + q] * (1.f / 1024.f) + EPS);
#pragma unroll
            for (int j = 0; j < 4; ++j) v[q][j] = *(const f32x4*)(C.out + O_Y + (size_t)(row0 + q) * DM + 256 * j + 4 * C.lane); }
#pragma unroll
        for (int q = 0; q < 2; ++q)
#pragma unroll
            for (int j = 0; j < 4; ++j) { const int c = 256 * j + 4 * C.lane; *(f32x4*)(C.out + O_Y + (size_t)(row0 + q) * DM + c) = v[q][j] * rs[q] * *(const f32x4*)(gf + c); } }
}

constexpr int LDS_BYTES = 131072 + 1024;
constexpr int NPHASE = 15;
__device__ __forceinline__ void run_phases(const Args& args, const int lo, const int hi) {
    extern __shared__ __attribute__((aligned(16))) unsigned char lds_raw[];
    Ctx C; C.in = args.in; C.out = args.out; C.ws = args.ws; C.lds = (LAS unsigned char*)lds_raw;
    C.tid = threadIdx.x; C.lane = C.tid & 63; C.wave = __builtin_amdgcn_readfirstlane(C.tid >> 6); C.G = gridDim.x; C.bx = blockIdx.x;
    C.vcu = (C.G % 8 == 0) ? (C.bx % 8) * (C.G / 8) + C.bx / 8 : C.bx;
    unsigned char* ws = args.ws; float* st = (float*)(ws + WS_STAT);
    float* SS1 = st, *SSQ = st + MT, *SSKV = st + 2 * MT, *SS2 = st + 3 * MT, *SS3 = st + 4 * MT, *SS0 = st + 5 * MT;
#ifndef MK_MASK
#define MK_MASK 0x1ffff
#endif
#define IN(k) (((MK_MASK >> (k)) & 1) && INX(k))
#define INX(k) ((k) >= 15 ? (hi - lo > 1 ? (lo <= 8 && 8 < hi) : (lo == (k))) : (lo <= (k) && (k) < hi))
#define SEAM(k) do { if (IN(k) && IN((k) + 1)) { xcd_barrier(xbar); } } while (0)
#define BF(off) ((bf16_t*)(ws + (off)))
    volatile LAS unsigned* bst = (volatile LAS unsigned*)(C.lds + 131072);
    if (C.tid < 2) bst[C.tid] = 0u;
    __syncthreads();
    XcdBarrier xbar; xbar.bar = (unsigned*)(ws + WS_BAR); xbar.x = 0; xbar.st = bst;
    if (hi - lo > 1) xbar = xcd_barrier_post((unsigned*)(ws + WS_BAR), bst);
    pg8::StaticOrder S;
    if (IN(0)) { p0_prologue(C); } SEAM(0);
    if (IN(1)) { pg8::Gemm g{BF(WS_AB), BF(W_13A), MT, 5632, 1024, 1024, 1024, 0, nullptr, nullptr}; S.init(MT, 5632, g.K, C.G, C.bx); EpiSwiglu E{BF(WS_ZA), SS0}; pg8::gemm_phase(C.lds, g, S, E); } SEAM(1);
    if (IN(2)) { pg8::Gemm g{BF(WS_ZA), BF(W_2A), MT, 1024, DFF, DFF, DFF, 0, (float*)(ws + WS_XC), (unsigned*)(ws + WS_CNT)}; S.init(MT, 1024, g.K, C.G, C.bx, 2); EpiResid<true> E{args.in[0], args.in[1], args.out, BF(WS_AB), SS1, 0.5f}; pg8::gemm_phase(C.lds, g, S, E); } SEAM(2);
    if (IN(3)) { pg8::Gemm g{BF(WS_AB), BF(W_IN), MT, ZW, 1024, 1024, 1024, 0, nullptr, nullptr}; S.init(MT, ZW, g.K, C.G, C.bx); EpiWin E{SS1, BF(WS_ZA), BF(WS_ZRX), BF(WS_ZRG), ws + WS_ZG8, SSQ, SSKV}; pg8::gemm_phase(C.lds, g, S, E); } SEAM(3);
    if (IN(4)) { p4_mid(C); } SEAM(4);
    if (IN(5)) { pg8::Gemm g{BF(WS_XC), BF(W_G), MT, 2048, 128, 1024, 128, 128, nullptr, nullptr}; S.init(MT, 2048, g.K, C.G, C.bx); EpiGates E{BF(WS_XC), args.in[20], args.in[22], (const float*)(ws + WS_SP), BF(WS_AB), BF(WS_ZRX)}; pg8::gemm_phase(C.lds, g, S, E); } SEAM(5);
    if (IN(6)) { p6_scan1(C); } SEAM(6);
    if (IN(7)) { p7_scan3(C); } SEAM(7);
    if (IN(8)) { pg8::Gemm g{BF(WS_ZA), BF(W_UQ), MT, 768, 384, 768, 384, 0, nullptr, nullptr}; S.init(MT, 768, g.K, C.G, C.bx); EpiQ E{SSQ, (const f32x2*)(ws + WS_CS), BF(WS_ZRX)}; pg8::gemm_phase(C.lds, g, S, E); }
    if (IN(15)) { pg8::Gemm g{BF(WS_CKV), BF(W_KV), KVROWS, 512, 256, 256, 256, 0, nullptr, nullptr}; S.init(KVROWS, 512, g.K, C.G, (C.bx + 120) % C.G); EpiPlain E{BF(WS_ZRG), 512}; pg8::gemm_phase(C.lds, g, S, E); }
    if (IN(16)) { pg8::Gemm g{BF(W_KV) + 512 * 256, BF(WS_CKV), 512, KVROWS, 256, 256, 256, 0, nullptr, nullptr}; S.init(512, KVROWS, g.K, C.G, (C.bx + 72) % C.G); EpiPlain E{BF(WS_AB), KVROWS}; pg8::gemm_phase(C.lds, g, S, E); }
    SEAM(8);
    if (IN(9)) { p9_attn(C); } SEAM(9);
#if MK_DUP == 9
    if (IN(9)) { p9_attn(C); } SEAM(9);
#endif
    if (IN(10)) {
        { pg8::Gemm g{BF(WS_ZA), BF(W_OA), MT, 1024, 512, 512, 512, 0, nullptr, nullptr}; S.init(MT, 1024, g.K, C.G, C.bx); EpiMerge<0> E{ws + WS_ZG8, BF(WS_ZRX), BF(WS_ZRG)}; pg8::gemm_phase(C.lds, g, S, E); }
        { pg8::Gemm g{BF(WS_XC), BF(W_OR), MT, 1024, 1024, 1024, 1024, 0, nullptr, nullptr}; S.init(MT, 1024, g.K, C.G, C.bx); EpiMerge<1> E{ws + WS_ZG8, BF(WS_ZRX), BF(WS_ZRG)}; pg8::gemm_phase(C.lds, g, S, E); }
    } SEAM(10);
    if (IN(11)) { pg8::Gemm g{BF(WS_ZRG), BF(W_OUT), MT, 1024, 1024, 1024, 1024, 0, (float*)(ws + WS_XC), (unsigned*)(ws + WS_CNT) + 8}; S.init(MT, 1024, g.K, C.G, C.bx, 2); EpiResid<true> E{args.out, args.out + (size_t)MP * DM, args.out, BF(WS_AB), SS2, 1.0f}; pg8::gemm_phase(C.lds, g, S, E); } SEAM(11);
    if (IN(12)) { pg8::Gemm g{BF(WS_AB), BF(W_13B), MT, 5632, 1024, 1024, 1024, 0, nullptr, nullptr}; S.init(MT, 5632, g.K, C.G, C.bx); EpiSwiglu E{BF(WS_ZA), SS2}; pg8::gemm_phase(C.lds, g, S, E); } SEAM(12);
    if (IN(13)) { pg8::Gemm g{BF(WS_ZA), BF(W_2B), MT, 1024, DFF, DFF, DFF, 0, (float*)(ws + WS_XC), (unsigned*)(ws + WS_CNT) + 16}; S.init(MT, 1024, g.K, C.G, C.bx, 2); EpiResid<false> E{args.out, args.out + (size_t)MP * DM, args.out, nullptr, SS3, 0.5f}; pg8::gemm_phase(C.lds, g, S, E); } SEAM(13);
    if (IN(14)) { p14_final(C); }
#undef IN
#undef SEAM
#undef BF
}
#if MK_ONE_LAUNCH
__global__ void __launch_bounds__(512, 2) mk_fwd(Args args) {
    run_phases(args, 0, NPHASE);
    if (args.ph_hi > NPHASE + 100) cg::this_grid().sync();
}
#endif
template <int P> __global__ void __launch_bounds__(512, 2) mk_phase(Args args) { run_phases(args, P, P + 1); }

extern "C" void kernel_launch(void* const* d_in, const int* in_sizes, int n_in, void* d_out, int out_size, void* d_ws, size_t ws_size, hipStream_t stream) {
    static int grid = 0;
    if (grid == 0) {
        if (n_in != 31 || ws_size < WS_END) { fprintf(stderr, "kernel_launch: unexpected n_in %d / ws %zu (need %zu)\n", n_in, ws_size, (size_t)WS_END); grid = -1; return; }
        int dev = 0, cus = 0, per_cu = 0;
        (void)hipGetDevice(&dev); (void)hipDeviceGetAttribute(&cus, hipDeviceAttributeMultiprocessorCount, dev);
#if MK_ONE_LAUNCH
        if (hipFuncSetAttribute((const void*)mk_fwd, hipFuncAttributeMaxDynamicSharedMemorySize, LDS_BYTES) != hipSuccess) { fprintf(stderr, "kernel_launch: hipFuncSetAttribute failed\n"); grid = -1; return; }
        if (hipOccupancyMaxActiveBlocksPerMultiprocessor(&per_cu, (const void*)mk_fwd, 512, LDS_BYTES) != hipSuccess || per_cu < 1) { fprintf(stderr, "kernel_launch: occupancy query says %d\n", per_cu); per_cu = 1; }
#else
#define SA(P) (void)hipFuncSetAttribute((const void*)mk_phase<P>, hipFuncAttributeMaxDynamicSharedMemorySize, LDS_BYTES);
        SA(0) SA(1) SA(2) SA(3) SA(4) SA(5) SA(6) SA(7) SA(8) SA(9) SA(10) SA(11) SA(12) SA(13) SA(14) SA(15) SA(16)
#undef SA
#endif
        (void)hipGetLastError();
        grid = cus * 1;
    }
    if (grid < 0) return;
    if (hipMemsetAsync((char*)d_ws + WS_BAR, 0, 16384, stream) != hipSuccess) { fprintf(stderr, "kernel_launch: memset failed\n"); return; }
    Args a{};
    for (int i = 0; i < 31; ++i) a.in[i] = (const float*)d_in[i];
    a.out = (float*)d_out; a.ws = (unsigned char*)d_ws;
#if MK_ONE_LAUNCH
    a.ph_lo = 0; a.ph_hi = NPHASE;
    void* kargs[] = {&a};
    hipError_t e = hipLaunchCooperativeKernel((const void*)mk_fwd, dim3(grid), dim3(512), kargs, LDS_BYTES, stream);
    if (e != hipSuccess) fprintf(stderr, "cooperative launch failed: %s (grid %d)\n", hipGetErrorString(e), grid);
#else
#define LP(P) hipLaunchKernelGGL(mk_phase<P>, dim3(grid), dim3(512), LDS_BYTES, stream, a);
    LP(0) LP(1) LP(2) LP(3) LP(4) LP(5) LP(6) LP(7) LP(8) LP(15) LP(16) LP(9) LP(10) LP(11) LP(12) LP(13) LP(14)
#undef LP
#endif
}
```

```cpp
#include <hip/hip_runtime.h>
#include <hip/hip_cooperative_groups.h>
#include <cstdio>
#include <cstdint>
namespace cg = cooperative_groups;

#ifndef MK_DUP
#define MK_DUP -1
#endif
#ifndef MK_ONE_LAUNCH
#define MK_ONE_LAUNCH 1
#endif

#define LAS __attribute__((address_space(3)))
typedef unsigned short bf16_t;
typedef short bf16x8 __attribute__((ext_vector_type(8)));
typedef float f32x4 __attribute__((ext_vector_type(4)));
typedef float f32x2 __attribute__((ext_vector_type(2)));
typedef float f32x16 __attribute__((ext_vector_type(16)));
typedef unsigned u32x4 __attribute__((ext_vector_type(4)));
typedef unsigned u32x2 __attribute__((ext_vector_type(2)));
typedef __bf16 bf16x2_t __attribute__((ext_vector_type(2)));

constexpr int DM = 1024, SEQ = 16384, NBP = 2, MP = NBP * SEQ, SBATCH = 8, SSEQ = 64, MS = SBATCH * SSEQ, MT = MP + MS, PAST = 1024;
constexpr int DFF = 2816, ZW = 4864, SKV = PAST + SSEQ, KVROWS = MP + SBATCH * SKV;
constexpr float EPS = 1e-6f;
constexpr float LOG2E = 1.4426950408889634f;
constexpr float QSCALE = 0.10206207261596577f * LOG2E;
constexpr size_t O_Y = 0, O_KVP = (size_t)MT * DM, O_KRP = O_KVP + (size_t)MP * 256, O_CVP = O_KRP + (size_t)MP * 32, O_HP = O_CVP + 2 * 3 * 1024,
                 O_KVS = O_HP + 2 * 1024, O_KRS = O_KVS + (size_t)MS * 256, O_CVS = O_KRS + (size_t)MS * 32, O_HS = O_CVS + 8 * 3 * 1024;
constexpr size_t MiB = 1u << 20;
constexpr size_t WS_STAT = 0;
constexpr size_t WS_CS = 1 * MiB;
constexpr size_t WS_SP = 3 * MiB;
constexpr size_t WS_SA = 4 * MiB, WS_SB = 6 * MiB;
constexpr size_t WS_W = 8 * MiB;
constexpr size_t W_13A = WS_W, W_2A = W_13A + (size_t)5632 * 1024 * 2, W_IN = W_2A + (size_t)1024 * 2816 * 2, W_UQ = W_IN + (size_t)ZW * 1024 * 2,
                 W_KV = W_UQ + (size_t)768 * 384 * 2, W_G = W_KV + (size_t)1024 * 256 * 2, W_OA = W_G + (size_t)2048 * 128 * 2, W_OR = W_OA + (size_t)1024 * 512 * 2,
                 W_OUT = W_OR + (size_t)1024 * 1024 * 2, W_13B = W_OUT + (size_t)1024 * 1024 * 2, W_2B = W_13B + (size_t)5632 * 1024 * 2, W_END = W_2B + (size_t)1024 * 2816 * 2;
static_assert(W_END <= 60 * MiB, "weights");
constexpr size_t SZ_ROW1K = (size_t)MT * 1024 * 2;
constexpr size_t WS_AB = 60 * MiB;
constexpr size_t WS_ZA = WS_AB + 66 * MiB;
constexpr size_t WS_ZRX = WS_ZA + (size_t)MT * 768 * 2;
constexpr size_t WS_ZRG = WS_ZRX + SZ_ROW1K;
constexpr size_t WS_ZG8 = WS_ZRG + SZ_ROW1K;
constexpr size_t WS_XC = WS_ZG8 + SZ_ROW1K;
constexpr size_t WS_CKV = WS_XC + SZ_ROW1K;
constexpr size_t WS_KR = WS_CKV + (size_t)KVROWS * 256 * 2;
constexpr size_t WS_END = WS_KR + (size_t)KVROWS * 32 * 2;
static_assert(WS_END <= 512 * MiB, "d_ws map");
static_assert(SZ_ROW1K <= 66 * MiB, "AB region");

__device__ __forceinline__ unsigned pk2(float lo, float hi) { f32x2 v = {lo, hi}; bf16x2_t b = __builtin_convertvector(v, bf16x2_t); return __builtin_bit_cast(unsigned, b); }
__device__ __forceinline__ float bflo(unsigned w) { return __uint_as_float(w << 16); }
__device__ __forceinline__ float bfhi(unsigned w) { return __uint_as_float(w & 0xffff0000u); }
__device__ __forceinline__ float bf1(bf16_t u) { return __uint_as_float(((unsigned)u) << 16); }
__device__ __forceinline__ float sigmoidf_(float x) { return __builtin_amdgcn_rcpf(1.f + __builtin_amdgcn_exp2f(-x * LOG2E)); }
__device__ __forceinline__ float wave_sum(float v) {
#pragma unroll
    for (int o = 1; o < 64; o <<= 1) v += __shfl_xor(v, o);
    return v;
}

namespace pg8 {
constexpr int BM = 256, BK = 64, HALF = 128, HTB = HALF * BK * 2, NXCD = 8, WGM = 8;
__host__ __device__ __forceinline__ int lds_byte(int r, int c) { const int st = (r >> 4) * 2 + (c >> 5), rr = r & 15, cc = c & 31, ob = rr * 64 + cc * 2; return st * 1024 + (ob ^ (((ob >> 9) & 1) << 5)); }
__host__ __device__ __forceinline__ void stage_rc(int b, int& R, int& C) { const int st = b / 1024, sb = b % 1024, swz = sb ^ (((sb >> 9) & 1) << 5); R = (st >> 1) * 16 + swz / 64; C = (st & 1) * 32 + (swz % 64) / 2; }
__host__ __device__ __forceinline__ int perm32(int rho) { const int n = rho >> 4, i = rho & 15; return 8 * (i >> 2) + 4 * n + (i & 3); }
struct Unit { int pm, pn, ks, nk, split; };
struct Gemm { const bf16_t* A; const bf16_t* Bt; int M, N, K, lda, ldb, a_pn_off; float* accbuf; unsigned* cnt; };
struct StaticOrder {
    int nM, nN, nwg, G, c, nt, NS, nmain;
    __device__ __forceinline__ void init(int M, int N, int K, int G_, int c_, int NS_ = 0) { nM = M / BM; nN = N / BM; nt = K / BK; NS = NS_; G = G_; c = c_;
        if (NS) { nM = 128; nmain = nM * nN; nwg = nmain + 2 * nN * NS; } else { nmain = nM * nN; nwg = nmain; } }
    __device__ __forceinline__ bool next(int i, Unit& u) const {
        const long L = (long)i * G + c; if (L >= nwg) return false;
        const bool sp = L >= nmain;
        const int NSd = NS ? NS : 1, j = sp ? (int)L - nmain : 0, uu = j / NSd, sl = j - uu * NSd, nks = nt / NSd;
        int wgid = sp ? 0 : (int)L; { const int q = nmain / NXCD, r = nmain % NXCD, xcd = wgid % NXCD, off = wgid / NXCD; wgid = (xcd < r ? xcd * (q + 1) : r * (q + 1) + (xcd - r) * q) + off; }
        const int nig = WGM * nN, gid = wgid / nig, fm = gid * WGM, gsz = (nM - fm) < WGM ? (nM - fm) : WGM;
        const int pm_m = fm + ((wgid % nig) % gsz), pn_m = (wgid % nig) / gsz;
        u.pm = __builtin_amdgcn_readfirstlane(sp ? 128 + uu / nN : pm_m); u.pn = __builtin_amdgcn_readfirstlane(sp ? uu % nN : pn_m);
        u.ks = __builtin_amdgcn_readfirstlane(sp ? sl * nks : 0); u.nk = __builtin_amdgcn_readfirstlane(sp ? nks : nt); u.split = sp ? 1 : 0; return true;
    }
};
template <class Epi>
__device__ __forceinline__ void gemm_phase(LAS unsigned char* lds, const Gemm g, const StaticOrder& S, const Epi& E) {
    int tid_ = threadIdx.x; asm volatile("" : "+v"(tid_));
    const int tid = tid_, wid = __builtin_amdgcn_readfirstlane(tid >> 6), lane = tid & 63, wr = wid >> 2, wc = wid & 3, fr = lane & 15, fq = lane >> 4;
    unsigned voffA[2], voffB[2];
#pragma unroll
    for (int i = 0; i < 2; ++i) { int R, C; stage_rc(tid * 16 + i * 8192, R, C); const int Rb = (R & ~31) + perm32(R & 31);
        voffA[i] = (unsigned)(R * g.lda + C) * 2u; voffB[i] = (unsigned)(Rb * g.ldb + C) * 2u; }
    const size_t kstep = (size_t)(BK * 2);
    const size_t hstepA = (size_t)HALF * g.lda * 2, hstepB = (size_t)HALF * g.ldb * 2;
    const size_t tstepA = 2 * hstepA, tstepB = 2 * hstepB;
    const unsigned ldsb = (unsigned)__builtin_amdgcn_readfirstlane((int)((unsigned)(uintptr_t)lds + (unsigned)wid * 1024u));
    const int aoff = lds_byte(wr * 64 + fr, fq * 8), boff = lds_byte(wc * 32 + fr, fq * 8);
#define PG8_SA(b, h) (((b) * 2 + (h)) * HTB)
#define PG8_SB(b, h) ((4 + (b) * 2 + (h)) * HTB)
#define PG8_STAGE(bufoff, gbase, voff) do { _Pragma("unroll") for (int _i = 0; _i < 2; ++_i) { unsigned _keep; \
        asm volatile("s_mov_b32 %0, m0\n\ts_mov_b32 m0, %1\n\ts_nop 0\n\tglobal_load_lds_dwordx4 %2, %3\n\ts_mov_b32 m0, %0" : "=&s"(_keep) : "s"(ldsb + (unsigned)((bufoff) + _i * 8192)), "v"((voff)[_i]), "s"((const char*)(gbase)) : "memory"); } } while (0)
#define PG8_LDA(dst, b, h) do { _Pragma("unroll") for (int m = 0; m < 4; ++m) _Pragma("unroll") for (int k = 0; k < 2; ++k) dst[m][k] = *(const LAS bf16x8*)(lds + PG8_SA(b, h) + aoff + m * 2048 + k * 1024); } while (0)
#define PG8_LDB(dst, b, h) do { _Pragma("unroll") for (int n = 0; n < 2; ++n) _Pragma("unroll") for (int k = 0; k < 2; ++k) dst[n][k] = *(const LAS bf16x8*)(lds + PG8_SB(b, h) + boff + n * 2048 + k * 1024); } while (0)
#define PG8_MMA(ai, bj, At, Bt) do { __builtin_amdgcn_s_setprio(1); _Pragma("unroll") for (int m = 0; m < 4; ++m) _Pragma("unroll") for (int n = 0; n < 2; ++n) _Pragma("unroll") for (int k = 0; k < 2; ++k) \
        acc[ai][bj][m][n] = __builtin_amdgcn_mfma_f32_16x16x32_bf16(Bt[n][k], At[m][k], acc[ai][bj][m][n], 0, 0, 0); __builtin_amdgcn_s_setprio(0); } while (0)
#define PG8_WAIT_V(n) asm volatile("s_waitcnt vmcnt(" #n ")" ::: "memory")
#define PG8_WAIT_L(n) asm volatile("s_waitcnt lgkmcnt(" #n ")" ::: "memory")
#define PG8_BAR __builtin_amdgcn_s_barrier()
#define PG8_SCHED __builtin_amdgcn_sched_barrier(0)
    Unit cur, nxt; int ui = 0;
    if (!S.next(0, cur)) return;
    f32x4 acc[2][2][4][2];
#pragma unroll
    for (int a = 0; a < 2; ++a)
#pragma unroll
        for (int b = 0; b < 2; ++b)
#pragma unroll
            for (int m = 0; m < 4; ++m)
#pragma unroll
                for (int n = 0; n < 2; ++n) acc[a][b][m][n] = (f32x4){0.f, 0.f, 0.f, 0.f};
    bf16x8 At[4][2], B0[2][2], B1[2][2];
    const char* cA = (const char*)g.A + (size_t)cur.pm * tstepA + (size_t)cur.pn * g.a_pn_off * 2 + (size_t)cur.ks * kstep; const char* cB = (const char*)g.Bt + (size_t)cur.pn * tstepB + (size_t)cur.ks * kstep;
    PG8_STAGE(PG8_SB(0, 0), cB, voffB); PG8_STAGE(PG8_SB(0, 1), cB + hstepB, voffB); PG8_STAGE(PG8_SA(0, 0), cA, voffA); PG8_STAGE(PG8_SA(0, 1), cA + hstepA, voffA);
    if (wr == 1) PG8_BAR;
    PG8_WAIT_V(2); PG8_BAR;
    PG8_STAGE(PG8_SB(1, 0), cB + kstep, voffB); PG8_STAGE(PG8_SA(1, 0), cA + kstep, voffA); PG8_STAGE(PG8_SB(1, 1), cB + hstepB + kstep, voffB);
    PG8_WAIT_V(6); PG8_BAR;
    for (;;) {
        const bool has_next = S.next(ui + 1, nxt);
        const char* nA = has_next ? (const char*)g.A + (size_t)nxt.pm * tstepA + (size_t)nxt.pn * g.a_pn_off * 2 + (size_t)nxt.ks * kstep : cA; const char* nB = has_next ? (const char*)g.Bt + (size_t)nxt.pn * tstepB + (size_t)nxt.ks * kstep : cB;
        const int nt = cur.nk;
#pragma nounroll
        for (int t = 0; t < nt; t += 2) {
            const bool last = (t == nt - 2);
            const char* a1 = cA + (size_t)(t + 1) * kstep;
            const char* a2 = last ? nA : cA + (size_t)(t + 2) * kstep; const char* b2 = last ? nB : cB + (size_t)(t + 2) * kstep;
            const char* a3 = a2 + kstep; const char* b3 = b2 + kstep;
            PG8_LDB(B0, 0, 0); PG8_LDB(B1, 0, 1); PG8_SCHED; PG8_LDA(At, 0, 0); PG8_STAGE(PG8_SA(1, 1), a1 + hstepA, voffA);
            PG8_WAIT_V(8); PG8_WAIT_L(0); PG8_BAR; PG8_MMA(0, 0, At, B0); PG8_MMA(0, 1, At, B1); PG8_BAR; PG8_SCHED;
            PG8_LDA(At, 0, 1); PG8_STAGE(PG8_SB(0, 0), b2, voffB); PG8_STAGE(PG8_SB(0, 1), b2 + hstepB, voffB); PG8_STAGE(PG8_SA(0, 0), a2, voffA);
            PG8_WAIT_V(8); PG8_WAIT_L(0); PG8_BAR; PG8_MMA(1, 0, At, B0); PG8_MMA(1, 1, At, B1); PG8_BAR; PG8_SCHED;
            PG8_LDB(B0, 1, 0); PG8_LDB(B1, 1, 1); PG8_SCHED; PG8_LDA(At, 1, 0); PG8_STAGE(PG8_SA(0, 1), a2 + hstepA, voffA);
            PG8_WAIT_V(8); PG8_WAIT_L(0); PG8_BAR; PG8_MMA(0, 0, At, B0); PG8_MMA(0, 1, At, B1); PG8_BAR; PG8_SCHED;
            PG8_LDA(At, 1, 1); PG8_STAGE(PG8_SB(1, 0), b3, voffB); PG8_STAGE(PG8_SB(1, 1), b3 + hstepB, voffB); PG8_STAGE(PG8_SA(1, 0), a3, voffA);
            PG8_WAIT_V(8); PG8_WAIT_L(0); PG8_BAR; PG8_MMA(1, 0, At, B0); PG8_MMA(1, 1, At, B1); PG8_BAR; PG8_SCHED;
        }
        if (wr == 0) PG8_BAR;
        bool run_epi = true;
        if (cur.split) {
            const int tix = (cur.pm - 128) * S.nN + cur.pn, myslice = cur.ks / cur.nk;
            float* T = g.accbuf + (size_t)tix * S.NS * 65536; const unsigned toff = (unsigned)tid * 16u;
            { float* P = T + (size_t)myslice * 65536; const __amdgpu_buffer_rsrc_t prs = __builtin_amdgcn_make_buffer_rsrc((void*)P, 0, 262144, 0x00020000);
#pragma unroll
              for (int a = 0; a < 2; ++a)
#pragma unroll
                for (int m = 0; m < 4; ++m)
#pragma unroll
                    for (int b = 0; b < 2; ++b)
#pragma unroll
                        for (int n = 0; n < 2; ++n) __builtin_amdgcn_raw_buffer_store_b128(__builtin_bit_cast(u32x4, acc[a][b][m][n]), prs, (int)(toff + (((a * 4 + m) * 2 + b) * 2 + n) * 8192), 0, 16); }
            volatile LAS unsigned* flg = (volatile LAS unsigned*)(lds + 131072 + 16);
            PG8_WAIT_V(0); PG8_BAR;
            if (tid == 0) { const unsigned old = __hip_atomic_fetch_add(g.cnt + tix, 1u, __ATOMIC_RELAXED, __HIP_MEMORY_SCOPE_AGENT); *flg = (old == (unsigned)(S.NS - 1)) ? 1u : 0u; }
            PG8_WAIT_L(0); PG8_BAR;
            const unsigned lastf = (unsigned)__builtin_amdgcn_readfirstlane((int)*flg);
            run_epi = lastf != 0u;
            if (lastf) {
#pragma nounroll
                for (int sl = 0; sl < S.NS; ++sl) { if (sl == myslice) continue;
                    const __amdgpu_buffer_rsrc_t qrs = __builtin_amdgcn_make_buffer_rsrc((void*)(T + (size_t)sl * 65536), 0, 262144, 0x00020000);
#pragma unroll
                    for (int a = 0; a < 2; ++a)
#pragma unroll
                        for (int m = 0; m < 4; ++m)
#pragma unroll
                            for (int b = 0; b < 2; ++b)
#pragma unroll
                                for (int n = 0; n < 2; ++n) acc[a][b][m][n] += __builtin_bit_cast(f32x4, __builtin_amdgcn_raw_buffer_load_b128(qrs, (int)(toff + (((a * 4 + m) * 2 + b) * 2 + n) * 8192), 0, 16)); }
            }
            PG8_WAIT_L(0); PG8_BAR;
        }
        if (run_epi) E(acc, cur, wr, wc, fr, fq);
        if (!has_next) break;
#pragma unroll
        for (int a = 0; a < 2; ++a)
#pragma unroll
            for (int b = 0; b < 2; ++b)
#pragma unroll
                for (int m = 0; m < 4; ++m)
#pragma unroll
                    for (int n = 0; n < 2; ++n) acc[a][b][m][n] = (f32x4){0.f, 0.f, 0.f, 0.f};
        cur = nxt; cA = nA; cB = nB; ++ui;
        if (wr == 1) PG8_BAR;
    }
    PG8_WAIT_V(0);
    PG8_BAR;
#undef PG8_SA
#undef PG8_SB
#undef PG8_STAGE
#undef PG8_LDA
#undef PG8_LDB
#undef PG8_MMA
#undef PG8_WAIT_V
#undef PG8_WAIT_L
#undef PG8_BAR
#undef PG8_SCHED
}
}
using pg8::Unit;
typedef const f32x4 (&AccRef)[2][2][4][2];

#define EPI_ROWS(...) _Pragma("unroll") for (int ai = 0; ai < 2; ++ai) _Pragma("unroll") for (int m = 0; m < 4; ++m) { const int row = row0 + ai * 128 + m * 16; __VA_ARGS__ __builtin_amdgcn_sched_barrier(0); }
__device__ __forceinline__ u32x4 pack8(f32x4 a, f32x4 b) { u32x4 w; w.x = pk2(a[0], a[1]); w.y = pk2(a[2], a[3]); w.z = pk2(b[0], b[1]); w.w = pk2(b[2], b[3]); return w; }
__device__ __forceinline__ float dot8(f32x4 a, f32x4 b) { return (a[0] * a[0] + a[1] * a[1]) + (a[2] * a[2] + a[3] * a[3]) + (b[0] * b[0] + b[1] * b[1]) + (b[2] * b[2] + b[3] * b[3]); }
__device__ __forceinline__ float red_fq(float s) { s += __shfl_xor(s, 16); s += __shfl_xor(s, 32); return s; }

struct EpiPlain {
    bf16_t* O; int ldc;
    __device__ __forceinline__ void operator()(AccRef acc, const Unit& u, int wr, int wc, int fr, int fq) const {
        const int row0 = u.pm * 256 + wr * 64 + fr, col0 = u.pn * 256 + wc * 32 + 8 * fq;
        EPI_ROWS(
            _Pragma("unroll") for (int bj = 0; bj < 2; ++bj) *(u32x4*)(O + (size_t)row * ldc + col0 + bj * 128) = pack8(acc[ai][bj][m][0], acc[ai][bj][m][1]);
        )
    }
};
struct EpiSwiglu {
    bf16_t* H; const float* ss;
    __device__ __forceinline__ void operator()(AccRef acc, const Unit& u, int wr, int wc, int fr, int fq) const {
        const int row0 = u.pm * 256 + wr * 64 + fr, col0 = u.pn * 128 + wc * 32 + 8 * fq;
        EPI_ROWS(
            const float rs = __builtin_amdgcn_rsqf(ss[row] * (1.f / 1024.f) + EPS);
            f32x4 o[2];
            _Pragma("unroll") for (int n = 0; n < 2; ++n) _Pragma("unroll") for (int i = 0; i < 4; ++i) { const float gg = acc[ai][0][m][n][i] * rs, uu = acc[ai][1][m][n][i] * rs; o[n][i] = gg * sigmoidf_(gg) * uu; }
            *(u32x4*)(H + (size_t)row * DFF + col0) = pack8(o[0], o[1]);
        )
    }
};
template <bool WB> struct EpiResid {
    const float* res0; const float* res1; float* out; bf16_t* ob; float* ss; float scale;
    __device__ __forceinline__ void operator()(AccRef acc, const Unit& u, int wr, int wc, int fr, int fq) const {
        const int row0 = u.pm * 256 + wr * 64 + fr, col0 = u.pn * 256 + wc * 32 + 8 * fq;
        EPI_ROWS(
            const float* rp = (row < MP) ? res0 + (size_t)row * DM : res1 + (size_t)(row - MP) * DM;
            float s = 0.f;
            _Pragma("unroll") for (int bj = 0; bj < 2; ++bj) { const int col = col0 + bj * 128;
                f32x4 v0 = *(const f32x4*)(rp + col) + acc[ai][bj][m][0] * scale, v1 = *(const f32x4*)(rp + col + 4) + acc[ai][bj][m][1] * scale;
                *(f32x4*)(out + (size_t)row * DM + col) = v0; *(f32x4*)(out + (size_t)row * DM + col + 4) = v1;
                if (WB) *(u32x4*)(ob + (size_t)row * DM + col) = pack8(v0, v1);
                s += dot8(v0, v1); }
            s = red_fq(s); if (fq == 0) unsafeAtomicAdd(ss + row, s);
        )
    }
};
__device__ __forceinline__ float gelu_tanh(float x) { const float y = 1.5957691216057308f * (x + 0.044715f * x * x * x); return x * sigmoidf_(y); }
struct EpiWin {
    const float* ss1; bf16_t* ZA; bf16_t* ZRX; bf16_t* ZRG; unsigned char* ZG8; float* ssq; float* sskv;
    __device__ __forceinline__ void operator()(AccRef acc, const Unit& u, int wr, int wc, int fr, int fq) const {
        const int row0 = u.pm * 256 + wr * 64 + fr, cw = wc * 32 + 8 * fq; const int pn = u.pn;
        EPI_ROWS(
            const float rs = __builtin_amdgcn_rsqf(ss1[row] * (1.f / 1024.f) + EPS);
            f32x4 v[2][2];
            _Pragma("unroll") for (int bj = 0; bj < 2; ++bj) { v[bj][0] = acc[ai][bj][m][0] * rs; v[bj][1] = acc[ai][bj][m][1] * rs; }
            if (pn < 3) {
                _Pragma("unroll") for (int bj = 0; bj < 2; ++bj) *(u32x4*)(ZA + (size_t)row * 768 + pn * 256 + bj * 128 + cw) = pack8(v[bj][0], v[bj][1]);
                float s = dot8(v[0][0], v[0][1]); if (pn != 1) s += dot8(v[1][0], v[1][1]);
                s = red_fq(s); if (fq == 0) unsafeAtomicAdd((pn == 2 ? sskv : ssq) + row, s);
            } else if (pn < 7) {
                _Pragma("unroll") for (int bj = 0; bj < 2; ++bj) *(u32x4*)(ZRX + (size_t)row * 1024 + (pn - 3) * 256 + bj * 128 + cw) = pack8(v[bj][0], v[bj][1]);
            } else if (pn < 11) {
                _Pragma("unroll") for (int bj = 0; bj < 2; ++bj) { _Pragma("unroll") for (int n = 0; n < 2; ++n) _Pragma("unroll") for (int i = 0; i < 4; ++i) v[bj][n][i] = gelu_tanh(v[bj][n][i]);
                    *(u32x4*)(ZRG + (size_t)row * 1024 + (pn - 7) * 256 + bj * 128 + cw) = pack8(v[bj][0], v[bj][1]); }
            } else {
                _Pragma("unroll") for (int bj = 0; bj < 2; ++bj) { unsigned w[2];
                    _Pragma("unroll") for (int n = 0; n < 2; ++n) { unsigned q = 0; _Pragma("unroll") for (int i = 0; i < 4; ++i) { const unsigned b = (unsigned)(sigmoidf_(v[bj][n][i]) * 255.f + 0.5f); q |= (b > 255u ? 255u : b) << (8 * i); } w[n] = q; }
                    *(u32x2*)(ZG8 + (size_t)row * 2048 + (pn - 11) * 256 + bj * 128 + cw) = (u32x2){w[0], w[1]}; }
            }
        )
    }
};
__device__ __forceinline__ int row_pos(int row) { return row < MP ? (row & (SEQ - 1)) : PAST + ((row - MP) & 63); }
struct EpiQ {
    const float* ssq; const f32x2* cs; bf16_t* Q;
    __device__ __forceinline__ void operator()(AccRef acc, const Unit& u, int wr, int wc, int fr, int fq) const {
        const int row0 = u.pm * 256 + wr * 64 + fr;
        EPI_ROWS(
            const float rs = __builtin_amdgcn_rsqf(ssq[row] * (1.f / 384.f) + EPS) * QSCALE; const int pos = row_pos(row);
            _Pragma("unroll") for (int bj = 0; bj < 2; ++bj) { const int G = u.pn * 8 + bj * 4 + wc, h = G / 3, part = G - 3 * h;
                f32x4 v0 = acc[ai][bj][m][0] * rs, v1 = acc[ai][bj][m][1] * rs; bf16_t* qp = Q + (size_t)row * 768 + h * 96;
                if (part < 2) *(u32x4*)(qp + part * 32 + 8 * fq) = pack8(v0, v1);
                else { const f32x2* c = cs + (size_t)pos * 16 + 4 * fq; f32x4 o1, o2;
                    _Pragma("unroll") for (int i = 0; i < 4; ++i) { const f32x2 t = c[i]; o1[i] = v0[i] * t.x - v1[i] * t.y; o2[i] = v1[i] * t.x + v0[i] * t.y; }
                    *(u32x2*)(qp + 64 + 4 * fq) = (u32x2){pk2(o1[0], o1[1]), pk2(o1[2], o1[3])}; *(u32x2*)(qp + 80 + 4 * fq) = (u32x2){pk2(o2[0], o2[1]), pk2(o2[2], o2[3])}; } }
        )
    }
};
struct EpiGates {
    const bf16_t* XC; const float* br; const float* bi; const float* sp; bf16_t* AL; bf16_t* BT;
    __device__ __forceinline__ void operator()(AccRef acc, const Unit& u, int wr, int wc, int fr, int fq) const {
        const int row0 = u.pm * 256 + wr * 64 + fr, ch0 = u.pn * 128 + wc * 32 + 8 * fq;
        EPI_ROWS(
            const bool reset = (row < MP) && ((row & (SEQ - 1)) == 0);
            const u32x4 xw = *(const u32x4*)(XC + (size_t)row * 1024 + ch0);
            u32x4 lw, bw;
            _Pragma("unroll") for (int n = 0; n < 2; ++n) {
                const float* brp = br; const float* bip = bi; const float* spp = sp; asm volatile("" : "+s"(brp), "+s"(bip), "+s"(spp));
                const f32x4 vbr = *(const f32x4*)(brp + ch0 + 4 * n), vbi = *(const f32x4*)(bip + ch0 + 4 * n), vsp = *(const f32x4*)(spp + ch0 + 4 * n);
                f32x4 la, bb;
                _Pragma("unroll") for (int i = 0; i < 4; ++i) {
                    const unsigned w = xw[n * 2 + (i >> 1)]; const float xc = (i & 1) ? bfhi(w) : bflo(w);
                    const float rg = sigmoidf_(acc[ai][0][m][n][i] + vbr[i]), ig = sigmoidf_(acc[ai][1][m][n][i] + vbi[i]);
                    float l = -rg * vsp[i]; l = __uint_as_float((pk2(l, l)) << 16);
                    const float a = __builtin_amdgcn_exp2f(l); float mult = __builtin_amdgcn_sqrtf(fmaxf(1.f - a * a, 0.f));
                    if (reset) { l = -1e30f; mult = 1.f; }
                    la[i] = l; bb[i] = mult * ig * xc; }
                lw[2 * n] = pk2(la[0], la[1]); lw[2 * n + 1] = pk2(la[2], la[3]); bw[2 * n] = pk2(bb[0], bb[1]); bw[2 * n + 1] = pk2(bb[2], bb[3]); }
            *(u32x4*)(AL + (size_t)row * 1024 + ch0) = lw; *(u32x4*)(BT + (size_t)row * 1024 + ch0) = bw;
        )
    }
};
template <int WHICH> struct EpiMerge {
    const unsigned char* ZG8; bf16_t* M1; bf16_t* MB;
    __device__ __forceinline__ void operator()(AccRef acc, const Unit& u, int wr, int wc, int fr, int fq) const {
        const int row0 = u.pm * 256 + wr * 64 + fr, col0 = u.pn * 256 + wc * 32 + 8 * fq;
        EPI_ROWS(
            _Pragma("unroll") for (int bj = 0; bj < 2; ++bj) { const int col = col0 + bj * 128;
                const u32x2 gw = *(const u32x2*)(ZG8 + (size_t)row * 2048 + WHICH * 1024 + col);
                f32x4 v[2];
                _Pragma("unroll") for (int n = 0; n < 2; ++n) _Pragma("unroll") for (int i = 0; i < 4; ++i) v[n][i] = acc[ai][bj][m][n][i] * ((float)((gw[n] >> (8 * i)) & 255u) * (1.f / 255.f));
                if (WHICH == 0) *(u32x4*)(M1 + (size_t)row * 1024 + col) = pack8(v[0], v[1]);
                else { const u32x4 mw = *(const u32x4*)(M1 + (size_t)row * 1024 + col);
                    _Pragma("unroll") for (int n = 0; n < 2; ++n) { v[n][0] += bflo(mw[2 * n]); v[n][1] += bfhi(mw[2 * n]); v[n][2] += bflo(mw[2 * n + 1]); v[n][3] += bfhi(mw[2 * n + 1]); }
                    *(u32x4*)(MB + (size_t)row * 1024 + col) = pack8(v[0], v[1]); } }
        )
    }
};


constexpr size_t WS_BAR = 1 * MiB - 16384;
constexpr size_t WS_CNT = WS_BAR + 14336;
#define XB_TMO      128
#define XB_XCNT(j)  (256  + 64 * (j))
#define XB_XSUB(j)  (1280 + 64 * (j))
#define XB_XGEN(j)  (2304 + 64 * (j))
#define XB_TOP      3328
#define XB_TOPGEN   3392
#define XCD_BAR_WORDS 3456
#define XB_SPIN_CAP (1u << 24)
__device__ __forceinline__ unsigned xb_ld(unsigned* p)              { return __hip_atomic_load(p, __ATOMIC_RELAXED, __HIP_MEMORY_SCOPE_AGENT); }
__device__ __forceinline__ unsigned xb_add(unsigned* p, unsigned v) { return __hip_atomic_fetch_add(p, v, __ATOMIC_RELAXED, __HIP_MEMORY_SCOPE_AGENT); }
__device__ __forceinline__ unsigned xb_xcc_id() { return (unsigned)__builtin_amdgcn_s_getreg((3 << 11) | 20) & 0xFu; }
#define XB_SPIN(cond, bar) do { unsigned _sp = 0; while (cond) { __builtin_amdgcn_s_sleep(1); \
    if ((++_sp & 255u) == 0u) { if (xb_ld(&(bar)[XB_TMO])) break; if (_sp > XB_SPIN_CAP) { atomicAdd(&(bar)[XB_TMO], 1u); break; } } } } while (0)
struct XcdBarrier { unsigned* bar; unsigned x; volatile LAS unsigned* st; };
__device__ __forceinline__ XcdBarrier xcd_barrier_post(unsigned* bar, volatile LAS unsigned* st) {
    XcdBarrier b; b.bar = bar; b.x = xb_xcc_id(); b.st = st;
    if (threadIdx.x == 0) (void)xb_add(&bar[XB_XCNT(b.x)], 1u);
    return b;
}
__device__ __forceinline__ void xcd_barrier_complete(unsigned* bar, unsigned x, unsigned& nloc, unsigned& nx) {
    const unsigned G = gridDim.x * gridDim.y * gridDim.z;
    unsigned sum, cnt, mine, sp = 0u;
    for (;;) {
        sum = 0u; cnt = 0u; mine = 0u;
#pragma unroll
        for (unsigned j = 0; j < 16; ++j) { const unsigned c = xb_ld(&bar[XB_XCNT(j)]); sum += c; cnt += (c > 0u) ? 1u : 0u; mine = (j == x) ? c : mine; }
        if (sum == G) break;
        __builtin_amdgcn_s_sleep(1);
        if ((++sp & 255u) == 0u) { if (xb_ld(&bar[XB_TMO])) break; if (sp > XB_SPIN_CAP) { atomicAdd(&bar[XB_TMO], 1u); break; } }
    }
    nloc = mine > 0u ? mine : 1u; nx = cnt > 0u ? cnt : 1u;
}
__device__ __forceinline__ void xcd_barrier(const XcdBarrier& b) {
    asm volatile("s_waitcnt vmcnt(0)" ::: "memory");
    __syncthreads();
    if (threadIdx.x == 0) {
        unsigned* bar = b.bar;
        __builtin_amdgcn_s_waitcnt(0);
        unsigned nloc = b.st[0], nx = b.st[1];
        if (nloc == 0u) { xcd_barrier_complete(bar, b.x, nloc, nx); b.st[0] = nloc; b.st[1] = nx; }
        const unsigned old = xb_add(&bar[XB_XSUB(b.x)], 1u);
        const unsigned gen = old / nloc;
        if (old + 1u == (gen + 1u) * nloc) {
            __builtin_amdgcn_fence(__ATOMIC_RELEASE, "agent");
            asm volatile("s_waitcnt vmcnt(0)" ::: "memory");
            const unsigned og = xb_add(&bar[XB_TOP], 1u);
            const unsigned tg = og / nx;
            if (og + 1u == (tg + 1u) * nx) xb_add(&bar[XB_TOPGEN], 1u);
            else XB_SPIN(xb_ld(&bar[XB_TOPGEN]) == tg, bar);
            __builtin_amdgcn_fence(__ATOMIC_ACQUIRE, "agent");
            xb_add(&bar[XB_XGEN(b.x)], 1u);
            asm volatile("s_waitcnt vmcnt(0)" ::: "memory");
        } else {
            XB_SPIN(xb_ld(&bar[XB_XGEN(b.x)]) == gen, bar);
            __builtin_amdgcn_fence(__ATOMIC_ACQUIRE, "agent");
            asm volatile("s_waitcnt vmcnt(0)" ::: "memory");
        }
    }
    __syncthreads();
}

struct Args { const float* in[31]; float* out; unsigned char* ws; int ph_lo, ph_hi; };
struct Ctx { const float* const* in; float* out; unsigned char* ws; LAS unsigned char* lds; int tid, lane, wave, G, bx, vcu; };

__device__ __forceinline__ void tr_item(const float* __restrict__ W, int ldw, const float* __restrict__ gain, bf16_t* WT, int ldt, int k0, int n0, int drow0, bool rperm, LAS float* scr, int lane) {
    float tv[32];
#pragma unroll
    for (int i = 0; i < 32; ++i) { const int kk = 2 * i + (lane >> 5); tv[i] = W[(size_t)(k0 + kk) * ldw + n0 + (lane & 31)]; }
    if (gain) {
#pragma unroll
        for (int i = 0; i < 32; ++i) tv[i] *= gain[k0 + 2 * i + (lane >> 5)]; }
#pragma unroll
    for (int i = 0; i < 32; ++i) scr[(2 * i + (lane >> 5)) * 33 + (lane & 31)] = tv[i];
    asm volatile("s_waitcnt lgkmcnt(0)" ::: "memory");
    const int c = lane & 7;
#pragma unroll
    for (int j = 0; j < 4; ++j) { const int n = (lane >> 3) + 8 * j; const LAS float* s = scr + (8 * c) * 33 + n;
        u32x4 o; o.x = pk2(s[0 * 33], s[1 * 33]); o.y = pk2(s[2 * 33], s[3 * 33]); o.z = pk2(s[4 * 33], s[5 * 33]); o.w = pk2(s[6 * 33], s[7 * 33]);
        const int dn = rperm ? (8 * ((n & 15) >> 2) + 4 * (n >> 4) + (n & 3)) : n;
        *(u32x4*)(WT + (size_t)(drow0 + dn) * ldt + k0 + 8 * c) = o; }
    asm volatile("s_waitcnt lgkmcnt(0)" ::: "memory");
}
__device__ __forceinline__ int map_row(int kind, int n0, int off) {
    if (kind == 0) return off + n0;
    if (kind == 1) return (n0 >> 7) * 256 + off + (n0 & 127);
    if (kind == 2) return n0 < 384 ? n0 : (n0 < 640 ? 512 + (n0 - 384) : (n0 < 672 ? 384 + (n0 - 640) : 768 + (n0 - 672)));
    if (kind == 3) return n0;
    const int h = n0 >> 7, j = n0 & 127; return (j < 64 ? 0 : 512) + h * 64 + (j & 63);
}
__device__ __forceinline__ void p0_prologue(const Ctx& C) {
    unsigned char* ws = C.ws; const float* const* in = C.in;
    LAS float* scr = (LAS float*)(C.lds + C.wave * 8704);
    const int gw = C.bx * 8 + C.wave, NGW = C.G * 8, gt = C.bx * 512 + C.tid, NGT = C.G * 512;
    { float* st = (float*)(ws + WS_STAT); for (int i = gt; i < 5 * MT; i += NGT) st[i] = 0.f;
      unsigned* wp = (unsigned*)(ws + W_IN + (size_t)416 * 1024 * 2); for (int i = gt; i < 96 * 1024 / 2; i += NGT) wp[i] = 0u; }
    { f32x2* cs = (f32x2*)(ws + WS_CS);
      for (int i = gt; i < SEQ * 16; i += NGT) { const int pos = i >> 4, j = i & 15;
          const double base = (j & 3) == 0 ? 1.0 : ((j & 3) == 1 ? 0.5623413251903491 : ((j & 3) == 2 ? 0.31622776601683794 : 0.17782794100389228));
          const double sc = (j >> 2) == 0 ? 1.0 : ((j >> 2) == 1 ? 0.1 : ((j >> 2) == 2 ? 0.01 : 0.001));
          const double a = (double)pos * (base * sc); const double kq = __builtin_rint(a * 0.6366197723675814); const double r = (a - kq * 1.5707963267948966) - kq * 6.123233995736766e-17;
          const double r2 = r * r;
          const double sn = r * (1.0 + r2 * (-1.0 / 6 + r2 * (1.0 / 120 + r2 * (-1.0 / 5040 + r2 * (1.0 / 362880 + r2 * (-1.0 / 39916800))))));
          const double cn = 1.0 + r2 * (-0.5 + r2 * (1.0 / 24 + r2 * (-1.0 / 720 + r2 * (1.0 / 40320 + r2 * (-1.0 / 3628800 + r2 * (1.0 / 479001600))))));
          const int q = (int)((long long)kq & 3); const double s = (q == 0) ? sn : (q == 1 ? cn : (q == 2 ? -sn : -cn)), c = (q == 0) ? cn : (q == 1 ? -sn : (q == 2 ? -cn : sn));
          cs[i] = (f32x2){(float)c, (float)s}; }
      float* sp = (float*)(ws + WS_SP); const float* lam = in[23];
      for (int i = gt; i < 1024; i += NGT) sp[i] = 8.f * LOG2E * log1pf(expf(-lam[i])); }
    constexpr int I_FF = 16 * 88, I_IN = 16 * 149, I_UQ = 6 * 24, I_KV = 4 * 32, I_OA = 8 * 32, I_SQ = 16 * 32, I_G = 2 * 4 * 8;
    constexpr int NITEMS = 6 * I_FF + I_IN + I_UQ + I_KV + I_OA + 2 * I_SQ + 2 * I_G;
#define TR_MAT(CNT, W_, K_, N_, GAIN_, WT_, LDT_, KIND_, OFF_) if (r < (CNT)) { const int nn_ = (N_) / 32, kb = r / nn_, nb = r % nn_, n0 = nb * 32; \
        tr_item(W_, N_, GAIN_, (bf16_t*)(ws + (WT_)), LDT_, kb * 64, n0, map_row(KIND_, n0, OFF_), (KIND_) == 3 && (n0 % 96 == 64), scr, C.lane); continue; } r -= (CNT);
    for (int it = gw; it < NITEMS; it += NGW) {
        int r = it;
        TR_MAT(I_FF, in[7], 1024, DFF, in[6], W_13A, 1024, 1, 0)
        TR_MAT(I_FF, in[8], 1024, DFF, in[6], W_13A, 1024, 1, 128)
        TR_MAT(I_FF, in[9], DFF, 1024, nullptr, W_2A, DFF, 0, 0)
        TR_MAT(I_FF, in[27], 1024, DFF, in[26], W_13B, 1024, 1, 0)
        TR_MAT(I_FF, in[28], 1024, DFF, in[26], W_13B, 1024, 1, 128)
        TR_MAT(I_FF, in[29], DFF, 1024, nullptr, W_2B, DFF, 0, 0)
        TR_MAT(I_IN, in[11], 1024, 4768, in[10], W_IN, 1024, 2, 0)
        TR_MAT(I_UQ, in[13], 384, 768, in[12], W_UQ, 384, 3, 0)
        TR_MAT(I_KV, in[15], 256, 1024, nullptr, W_KV, 256, 4, 0)
        TR_MAT(I_OA, in[16], 512, 1024, nullptr, W_OA, 512, 0, 0)
        TR_MAT(I_SQ, in[24], 1024, 1024, nullptr, W_OR, 1024, 0, 0)
        TR_MAT(I_SQ, in[25], 1024, 1024, nullptr, W_OUT, 1024, 0, 0)
        if (r < I_G) { const int blk = r >> 3, q = r & 7; tr_item(in[19] + (size_t)blk * 16384, 128, nullptr, (bf16_t*)(ws + W_G), 128, (q >> 2) * 64, (q & 3) * 32, blk * 256 + (q & 3) * 32, false, scr, C.lane); continue; } r -= I_G;
        { const int blk = r >> 3, q = r & 7; tr_item(in[21] + (size_t)blk * 16384, 128, nullptr, (bf16_t*)(ws + W_G), 128, (q >> 2) * 64, (q & 3) * 32, blk * 256 + 128 + (q & 3) * 32, false, scr, C.lane); }
    }
#undef TR_MAT
    { bf16_t* AB = (bf16_t*)(ws + WS_AB); float* ss0 = (float*)(ws + WS_STAT) + 5 * MT;
      for (int row0 = gw * 4; row0 < MT; row0 += NGW * 4) {
          f32x4 v[4][4];
#pragma unroll
          for (int q = 0; q < 4; ++q) { const int row = row0 + q; const float* xr = row < MP ? in[0] + (size_t)row * DM : in[1] + (size_t)(row - MP) * DM;
#pragma unroll
              for (int j = 0; j < 4; ++j) v[q][j] = __builtin_nontemporal_load((const f32x4*)(xr + 256 * j + 4 * C.lane)); }
#pragma unroll
          for (int q = 0; q < 4; ++q) { const int row = row0 + q; float s = 0.f;
#pragma unroll
              for (int j = 0; j < 4; ++j) s += (v[q][j][0] * v[q][j][0] + v[q][j][1] * v[q][j][1]) + (v[q][j][2] * v[q][j][2] + v[q][j][3] * v[q][j][3]);
              s = wave_sum(s); if (C.lane == 0) ss0[row] = s;
#pragma unroll
              for (int j = 0; j < 4; ++j) *(u32x2*)(AB + (size_t)row * DM + 256 * j + 4 * C.lane) = (u32x2){pk2(v[q][j][0], v[q][j][1]), pk2(v[q][j][2], v[q][j][3])}; } } }
    { bf16_t* CKV = (bf16_t*)(ws + WS_CKV); bf16_t* KR = (bf16_t*)(ws + WS_KR);
      for (int r = gw; r < SBATCH * PAST; r += NGW) { const int b = r >> 10, p = r & 1023; const size_t kr = (size_t)MP + b * SKV + p;
          const f32x4 v = *(const f32x4*)(in[2] + (size_t)r * 256 + 4 * C.lane); *(u32x2*)(CKV + kr * 256 + 4 * C.lane) = (u32x2){pk2(v[0], v[1]), pk2(v[2], v[3])};
          if (C.lane < 8) { const f32x4 w = *(const f32x4*)(in[3] + (size_t)r * 32 + 4 * C.lane); *(u32x2*)(KR + kr * 32 + 4 * C.lane) = (u32x2){pk2(w[0], w[1]), pk2(w[2], w[3])}; } } }
}

__device__ __forceinline__ void p4_mid(const Ctx& C) {
    unsigned char* ws = C.ws; const float* const* in = C.in; const int lane = C.lane;
    const bf16_t* ZA = (const bf16_t*)(ws + WS_ZA); const bf16_t* ZRX = (const bf16_t*)(ws + WS_ZRX);
    bf16_t* CKV = (bf16_t*)(ws + WS_CKV); bf16_t* KR = (bf16_t*)(ws + WS_KR); bf16_t* XC = (bf16_t*)(ws + WS_XC);
    const float* sskv = (const float*)(ws + WS_STAT) + 2 * MT; const f32x2* cs = (const f32x2*)(ws + WS_CS);
    const int gw = C.bx * 8 + C.wave, NGW = C.G * 8;
    const f32x4 gkv = *(const f32x4*)(in[14] + 4 * lane);
    for (int row0 = gw * 4; row0 < MT; row0 += NGW * 4) {
        u32x2 zw[4]; float sk[4];
#pragma unroll
        for (int i = 0; i < 4; ++i) { zw[i] = *(const u32x2*)(ZA + (size_t)(row0 + i) * 768 + 512 + 4 * lane); sk[i] = sskv[row0 + i]; }
        { const int rr = row0 + (lane >> 4), j = lane & 15; const bool isP = rr < MP; const int r2 = rr - MP;
          const int b = isP ? (rr >> 14) : (r2 >> 6), t = isP ? (rr & (SEQ - 1)) : (r2 & 63), pos = isP ? t : PAST + t; const size_t krow = isP ? (size_t)rr : (size_t)MP + b * SKV + PAST + t;
          const float x1 = bf1(ZA[(size_t)rr * 768 + 384 + j]), x2 = bf1(ZA[(size_t)rr * 768 + 400 + j]); const f32x2 tcs = cs[(size_t)pos * 16 + j];
          const float o1 = x1 * tcs.x - x2 * tcs.y, o2 = x2 * tcs.x + x1 * tcs.y;
          float* o = isP ? C.out + O_KRP + (size_t)rr * 32 : C.out + O_KRS + (size_t)r2 * 32; o[j] = o1; o[16 + j] = o2;
          KR[krow * 32 + j] = (bf16_t)(pk2(o1, o1) & 0xffffu); KR[krow * 32 + 16 + j] = (bf16_t)(pk2(o2, o2) & 0xffffu); }
#pragma unroll
        for (int i = 0; i < 4; ++i) { const int row = row0 + i; const bool isP = row < MP; const int r2 = row - MP;
            const int b = isP ? (row >> 14) : (r2 >> 6), t = isP ? (row & (SEQ - 1)) : (r2 & 63); const size_t krow = isP ? (size_t)row : (size_t)MP + b * SKV + PAST + t;
            const float rk = __builtin_amdgcn_rsqf(sk[i] * (1.f / 256.f) + EPS);
            f32x4 c = {bflo(zw[i].x) * rk * gkv[0], bfhi(zw[i].x) * rk * gkv[1], bflo(zw[i].y) * rk * gkv[2], bfhi(zw[i].y) * rk * gkv[3]};
            float* o = isP ? C.out + O_KVP + (size_t)row * 256 : C.out + O_KVS + (size_t)r2 * 256; *(f32x4*)(o + 4 * lane) = c;
            *(u32x2*)(CKV + krow * 256 + 4 * lane) = (u32x2){pk2(c[0], c[1]), pk2(c[2], c[3])}; }
    }
    for (int it = gw; it < (MT / 16) * 4; it += NGW) {
        const int r0 = (it >> 2) * 16, ch = 256 * (it & 3) + 4 * lane; const bool isP = r0 < MP; const int r2 = r0 - MP;
        const int b = isP ? (r0 >> 14) : (r2 >> 6), t0 = isP ? (r0 & (SEQ - 1)) : (r2 & 63), S = isP ? SEQ : SSEQ;
        u32x2 xw[19];
#pragma unroll
        for (int i = 0; i < 16; ++i) xw[3 + i] = *(const u32x2*)(ZRX + (size_t)(r0 + i) * 1024 + ch);
        if (t0 > 0) {
#pragma unroll
            for (int i = 0; i < 3; ++i) xw[i] = *(const u32x2*)(ZRX + (size_t)(r0 - 3 + i) * 1024 + ch);
        } else if (!isP) {
#pragma unroll
            for (int i = 0; i < 3; ++i) { const f32x4 sv = *(const f32x4*)(in[4] + ((size_t)b * 3 + i) * 1024 + ch); xw[i] = (u32x2){pk2(sv[0], sv[1]), pk2(sv[2], sv[3])}; }
        } else {
#pragma unroll
            for (int i = 0; i < 3; ++i) xw[i] = (u32x2){0u, 0u};
        }
        const f32x4 cb = *(const f32x4*)(in[18] + ch), w0 = *(const f32x4*)(in[17] + ch), w1 = *(const f32x4*)(in[17] + 1024 + ch), w2 = *(const f32x4*)(in[17] + 2048 + ch), w3 = *(const f32x4*)(in[17] + 3072 + ch);
#define UNP(w) ((f32x4){bflo((w).x), bfhi((w).x), bflo((w).y), bfhi((w).y)})
#pragma unroll
        for (int i = 0; i < 16; ++i) { const f32x4 a = cb + UNP(xw[i]) * w0 + UNP(xw[i + 1]) * w1 + UNP(xw[i + 2]) * w2 + UNP(xw[i + 3]) * w3;
            *(u32x2*)(XC + (size_t)(r0 + i) * 1024 + ch) = (u32x2){pk2(a[0], a[1]), pk2(a[2], a[3])}; }
        if (t0 + 16 == S) { float* o = (isP ? C.out + O_CVP : C.out + O_CVS) + (size_t)b * 3 * 1024 + ch;
#pragma unroll
            for (int i = 0; i < 3; ++i) *(f32x4*)(o + (size_t)i * 1024) = UNP(xw[16 + i]); }
#undef UNP
    }
}

__device__ __forceinline__ f32x4 ld_bf4(const bf16_t* p) { const u32x2 w = *(const u32x2*)p; return (f32x4){bflo(w.x), bfhi(w.x), bflo(w.y), bfhi(w.y)}; }
__device__ __forceinline__ f32x4 exp2v(f32x4 v) { return (f32x4){__builtin_amdgcn_exp2f(v[0]), __builtin_amdgcn_exp2f(v[1]), __builtin_amdgcn_exp2f(v[2]), __builtin_amdgcn_exp2f(v[3])}; }
__device__ __forceinline__ void p6_scan1(const Ctx& C) {
    const bf16_t* AL = (const bf16_t*)(C.ws + WS_AB); const bf16_t* BT = (const bf16_t*)(C.ws + WS_ZRX); float* SA = (float*)(C.ws + WS_SA); float* SB = (float*)(C.ws + WS_SB);
    for (int u = C.bx; u < 256; u += C.G) { const int chunk = 2 * u + (C.tid >> 8), c4 = (C.tid & 255) * 4; const size_t base = (size_t)chunk * 64 * 1024 + c4;
        f32x4 A = {1.f, 1.f, 1.f, 1.f}, B = {0.f, 0.f, 0.f, 0.f};
#pragma unroll 8
        for (int r = 0; r < 64; ++r) { const f32x4 a = exp2v(ld_bf4(AL + base + (size_t)r * 1024)), b = ld_bf4(BT + base + (size_t)r * 1024); B = a * B + b; A = A * a; }
        *(f32x4*)(SA + (size_t)chunk * 1024 + c4) = A; *(f32x4*)(SB + (size_t)chunk * 1024 + c4) = B; }
}
__device__ __forceinline__ void p7_scan3(const Ctx& C) {
    const bf16_t* AL = (const bf16_t*)(C.ws + WS_AB); const bf16_t* BT = (const bf16_t*)(C.ws + WS_ZRX); const bf16_t* ZRG = (const bf16_t*)(C.ws + WS_ZRG);
    const float* SA = (const float*)(C.ws + WS_SA); const float* SB = (const float*)(C.ws + WS_SB); bf16_t* HG = (bf16_t*)(C.ws + WS_XC);
    for (int u = C.bx; u < 260; u += C.G) {
        f32x4 h; size_t base; int nchunkpre = 0, cb = 0, c4; float* hout = nullptr;
        if (u < 256) { const int chunk = 2 * u + (C.tid >> 8); c4 = (C.tid & 255) * 4; base = (size_t)chunk * 64 * 1024 + c4; nchunkpre = chunk & 255; cb = chunk - nchunkpre; h = (f32x4){0.f, 0.f, 0.f, 0.f};
            if (nchunkpre == 255) hout = C.out + O_HP + (size_t)(chunk >> 8) * 1024 + c4; }
        else { const int idx = (u - 256) * 512 + C.tid, b = idx >> 8; c4 = (idx & 255) * 4; base = ((size_t)MP + b * 64) * 1024 + c4; h = *(const f32x4*)(C.in[5] + (size_t)b * 1024 + c4); hout = C.out + O_HS + (size_t)b * 1024 + c4; }
#pragma unroll 16
        for (int c = 0; c < nchunkpre; ++c) { const f32x4 a = *(const f32x4*)(SA + (size_t)(cb + c) * 1024 + c4), b = *(const f32x4*)(SB + (size_t)(cb + c) * 1024 + c4); h = a * h + b; }
#pragma unroll 8
        for (int r = 0; r < 64; ++r) { const f32x4 a = exp2v(ld_bf4(AL + base + (size_t)r * 1024)), b = ld_bf4(BT + base + (size_t)r * 1024), g = ld_bf4(ZRG + base + (size_t)r * 1024);
            h = a * h + b; const f32x4 o = h * g; *(u32x2*)(HG + base + (size_t)r * 1024) = (u32x2){pk2(o[0], o[1]), pk2(o[2], o[3])}; }
        if (hout) *(f32x4*)hout = h;
    }
}

constexpr int KT_STRIDE = 208, KT_BYTES = 64 * KT_STRIDE, VT_STRIDE = 144, VT_BYTES = 64 * VT_STRIDE;
constexpr int AT_K0 = 0, AT_V0 = 2 * KT_BYTES;
#define SBAR() __builtin_amdgcn_sched_barrier(0)
#define AT_X(P0, P1, i) ((i) < 16 ? P0[(i) & 15] : P1[(i) & 15])
#define AT_MFMA __builtin_amdgcn_mfma_f32_32x32x16_bf16
template <bool FIRST>
__device__ __forceinline__ void at_step(f32x16& o0, f32x16& o1, f32x16& negm, float& mrun, float& lrun, const bf16x8 (&qr)[6], const LAS unsigned char* Kb, const LAS unsigned char* Vb) {
    f32x16 C0, C1;
    {   bf16x8 ka = *(const LAS bf16x8*)(Kb);
#define AT_GA(g) { bf16x8 na = ka; if ((g) < 5) na = *(const LAS bf16x8*)(Kb + ((g) + 1) * 32); else na = *(const LAS bf16x8*)(Kb + 32 * KT_STRIDE); \
        if ((g) == 0) C0 = AT_MFMA(ka, qr[0], negm, 0, 0, 0); else C0 = AT_MFMA(ka, qr[g], C0, 0, 0, 0); ka = na; }
        AT_GA(0) AT_GA(1) AT_GA(2) AT_GA(3) AT_GA(4) AT_GA(5)
#undef AT_GA
#define AT_GA(g) { bf16x8 na = ka; if ((g) < 5) na = *(const LAS bf16x8*)(Kb + 32 * KT_STRIDE + ((g) + 1) * 32); \
        if ((g) == 0) C1 = AT_MFMA(ka, qr[0], negm, 0, 0, 0); else C1 = AT_MFMA(ka, qr[g], C1, 0, 0, 0); ka = na; }
        AT_GA(0) AT_GA(1) AT_GA(2) AT_GA(3) AT_GA(4) AT_GA(5)
#undef AT_GA
    }
    bf16x8 va = *(const LAS bf16x8*)(Vb), vb = *(const LAS bf16x8*)(Vb + 32 * VT_STRIDE);
    float sacc = 0.f;
#define AT_GB(s4, CC, j) { bf16x8 na = va, nb = vb; if ((s4) < 3) { na = *(const LAS bf16x8*)(Vb + ((s4) + 1) * 32); nb = *(const LAS bf16x8*)(Vb + 32 * VT_STRIDE + ((s4) + 1) * 32); } \
    const float e0 = __builtin_amdgcn_exp2f(CC[(j)]), e1 = __builtin_amdgcn_exp2f(CC[(j) + 1]), e2 = __builtin_amdgcn_exp2f(CC[(j) + 2]), e3 = __builtin_amdgcn_exp2f(CC[(j) + 3]); \
    const float e4 = __builtin_amdgcn_exp2f(CC[(j) + 4]), e5 = __builtin_amdgcn_exp2f(CC[(j) + 5]), e6 = __builtin_amdgcn_exp2f(CC[(j) + 6]), e7 = __builtin_amdgcn_exp2f(CC[(j) + 7]); \
    sacc += ((e0 + e1) + (e2 + e3)) + ((e4 + e5) + (e6 + e7)); \
    const u32x4 w = {pk2(e0, e1), pk2(e2, e3), pk2(e4, e5), pk2(e6, e7)}; const bf16x8 pb = __builtin_bit_cast(bf16x8, w); \
    o0 = AT_MFMA(va, pb, o0, 0, 0, 0); o1 = AT_MFMA(vb, pb, o1, 0, 0, 0); va = na; vb = nb; }
    {   float rm = fmaxf(fmaxf(C0[0], C0[1]), C0[2]);
#pragma unroll
        for (int r = 3; r < 15; r += 2) rm = fmaxf(fmaxf(rm, C0[r]), C0[r + 1]);
        rm = fmaxf(rm, C0[15]);
        rm = fmaxf(rm, __shfl_xor(rm, 32));
        if (FIRST) { const float dl = rm; mrun = dl;
#pragma unroll
            for (int r = 0; r < 16; ++r) { C0[r] -= dl; C1[r] -= dl; negm[r] = -mrun; }
            asm volatile("" : "+v"(negm));
        } else if (__builtin_expect(__any(rm > 8.f), 0)) { const float dl = fmaxf(rm, 0.f); mrun += dl;
#pragma unroll
            for (int r = 0; r < 16; ++r) { C0[r] -= dl; C1[r] -= dl; negm[r] = -mrun; }
            asm volatile("" : "+v"(negm));
            const float f = __builtin_amdgcn_exp2f(-dl); lrun *= f;
#pragma unroll
            for (int r = 0; r < 16; ++r) { o0[r] *= f; o1[r] *= f; } }
    }
    AT_GB(0, C0, 0) AT_GB(1, C0, 8)
    lrun += sacc; sacc = 0.f;
    {   float rm = fmaxf(fmaxf(C1[0], C1[1]), C1[2]);
#pragma unroll
        for (int r = 3; r < 15; r += 2) rm = fmaxf(fmaxf(rm, C1[r]), C1[r + 1]);
        rm = fmaxf(rm, C1[15]);
        rm = fmaxf(rm, __shfl_xor(rm, 32));
        if (__builtin_expect(__any(rm > 8.f), 0)) { const float dl = fmaxf(rm, 0.f); mrun += dl;
#pragma unroll
            for (int r = 0; r < 16; ++r) { C1[r] -= dl; negm[r] = -mrun; }
            asm volatile("" : "+v"(negm));
            const float f = __builtin_amdgcn_exp2f(-dl); lrun *= f;
#pragma unroll
            for (int r = 0; r < 16; ++r) { o0[r] *= f; o1[r] *= f; } }
    }
    AT_GB(2, C1, 0) AT_GB(3, C1, 8)
#undef AT_GB
    lrun += sacc;
}
__device__ __forceinline__ void attn_unit(const Ctx& C, int qrow0, int krow0, int h, int NT, int ntw) {
    const bf16_t* Q = (const bf16_t*)(C.ws + WS_ZRX); const bf16_t* KN = (const bf16_t*)(C.ws + WS_ZRG); const bf16_t* KRp = (const bf16_t*)(C.ws + WS_KR);
    const bf16_t* VT = (const bf16_t*)(C.ws + WS_AB); bf16_t* O = (bf16_t*)(C.ws + WS_ZA);
    int tid_ = threadIdx.x; asm volatile("" : "+v"(tid_));
    const int tid = tid_, lane = tid & 63, wid = __builtin_amdgcn_readfirstlane(tid >> 6), r32 = lane & 31, hi = lane >> 5;
    LAS unsigned char* lds = C.lds;
    bf16x8 qr[6];
    if (ntw > 0) {
#pragma unroll
        for (int ds = 0; ds < 6; ++ds) qr[ds] = *(const bf16x8*)(Q + (size_t)(qrow0 + wid * 32 + r32) * 768 + h * 96 + ds * 16 + hi * 8);
    } else {
#pragma unroll
        for (int ds = 0; ds < 6; ++ds) qr[ds] = (bf16x8){0, 0, 0, 0, 0, 0, 0, 0};
    }
    const bf16_t* ksrc = KN + (size_t)(krow0 + (tid >> 3)) * 512 + h * 64 + (tid & 7) * 8;
    const bf16_t* rsrc = KRp + (size_t)(krow0 + ((tid & 255) >> 2)) * 32 + (tid & 3) * 8;
    const bf16_t* vsrc = VT + (size_t)(h * 64 + (tid >> 3)) * KVROWS + krow0 + (tid & 7) * 8;
    const int kdst = (tid >> 3) * KT_STRIDE + (tid & 7) * 16, rdst = ((tid & 255) >> 2) * KT_STRIDE + 128 + (tid & 3) * 16;
    const int vdst = AT_V0 + (tid >> 3) * VT_STRIDE + (((tid & 7) >> 1) * 16 + 4 * (tid & 1)) * 2;
    u32x4 kA, rA, vA, kB, rB, vB;
#define AT_LOAD(t, K_, R_, V_) do { K_ = *(const u32x4*)(ksrc + (size_t)(t) * 64 * 512); if (tid < 256) R_ = *(const u32x4*)(rsrc + (size_t)(t) * 64 * 32); V_ = *(const u32x4*)(vsrc + (size_t)(t) * 64); } while (0)
#define AT_STORE(t, K_, R_, V_) do { LAS unsigned char* sk = lds + AT_K0 + ((t) & 1) * KT_BYTES; *(LAS u32x4*)(sk + kdst) = K_; if (tid < 256) *(LAS u32x4*)(sk + rdst) = R_; \
        LAS unsigned char* sv = lds + ((t) & 1) * VT_BYTES; *(LAS u32x2*)(sv + vdst) = (u32x2){V_.x, V_.y}; *(LAS u32x2*)(sv + vdst + 16) = (u32x2){V_.z, V_.w}; } while (0)
#define AT_BAR() asm volatile("s_waitcnt lgkmcnt(0)\n\ts_barrier" ::: "memory")
    f32x16 o0 = {}, o1 = {}, negm = {}; float mrun = 0.f, lrun = 0.f;
    asm volatile("" : "+v"(negm));
    if (wid >= 4) __builtin_amdgcn_s_setprio(1);
    const LAS unsigned char* Kl = lds + AT_K0 + r32 * KT_STRIDE + hi * 16; const LAS unsigned char* Vl = lds + AT_V0 + r32 * VT_STRIDE + hi * 16;
    AT_LOAD(0, kA, rA, vA); if (NT > 1) AT_LOAD(1, kB, rB, vB);
    AT_STORE(0, kA, rA, vA);
    AT_BAR();
    if (NT > 2) AT_LOAD(2, kA, rA, vA);
    if (ntw > 0) at_step<true>(o0, o1, negm, mrun, lrun, qr, Kl, Vl);
    if (NT > 1) AT_STORE(1, kB, rB, vB);
    AT_BAR();
    int t = 1;
#pragma nounroll
    for (; t + 1 < NT; t += 2) {
        if (t + 2 < NT) AT_LOAD(t + 2, kB, rB, vB);
        if (t < ntw) at_step<false>(o0, o1, negm, mrun, lrun, qr, Kl + KT_BYTES, Vl + VT_BYTES);
        AT_STORE(t + 1, kA, rA, vA);
        AT_BAR();
        if (t + 3 < NT) AT_LOAD(t + 3, kA, rA, vA);
        if (t + 1 < ntw) at_step<false>(o0, o1, negm, mrun, lrun, qr, Kl, Vl);
        if (t + 2 < NT) AT_STORE(t + 2, kB, rB, vB);
        AT_BAR();
    }
    if (t < NT) {
        if (t < ntw) at_step<false>(o0, o1, negm, mrun, lrun, qr, Kl + KT_BYTES, Vl + VT_BYTES);
        AT_BAR();
    }
#undef AT_LOAD
#undef AT_STORE
#undef AT_BAR
    __builtin_amdgcn_s_setprio(0);
    if (ntw > 0) {
        const float lt = lrun + __shfl_xor(lrun, 32), inv = 1.f / lt;
        bf16_t* op = O + (size_t)(qrow0 + wid * 32 + r32) * 512 + h * 64 + 4 * hi;
#pragma unroll
        for (int g = 0; g < 4; ++g) {
            *(u32x2*)(op + 8 * g) = (u32x2){pk2(o0[4 * g] * inv, o0[4 * g + 1] * inv), pk2(o0[4 * g + 2] * inv, o0[4 * g + 3] * inv)};
            *(u32x2*)(op + 32 + 8 * g) = (u32x2){pk2(o1[4 * g] * inv, o1[4 * g + 1] * inv), pk2(o1[4 * g + 2] * inv, o1[4 * g + 3] * inv)}; }
    }
}
__device__ __forceinline__ void p9_attn(const Ctx& C) {
    for (int k = C.vcu; k < 576; k += C.G) {
        if (k < 512) { const int bh = k >> 5, j = k & 31, b = bh >> 3, h = bh & 7;
#pragma unroll 1
            for (int e = 0; e < 2; ++e) { const int qb = e == 0 ? 63 - j : j; attn_unit(C, b * SEQ + 256 * qb, b * SEQ, h, 4 * qb + 4, 4 * qb + (C.wave >> 1) + 1); } }
        else { const int s = k - 512, bs = s >> 3, h = s & 7; attn_unit(C, MP + bs * 64, MP + bs * SKV, h, 17, C.wave < 2 ? 17 : 0); }
    }
}
__device__ __forceinline__ void p14_final(const Ctx& C) {
    const float* ss3 = (const float*)(C.ws + WS_STAT) + 4 * MT; const float* gf = C.in[30];
    const int gw = C.bx * 8 + C.wave, NGW = C.G * 8;
    for (int row0 = gw * 4; row0 < MT; row0 += NGW * 4) {
        f32x4 v[4][4]; float rs[4];
#pragma unroll
        for (int q = 0; q < 4; ++q) { rs[q] = __builtin_amdgcn_rsqf(ss3[row0 + q] * (1.f / 1024.f) + EPS);
#pragma unroll
            for (int j = 0; j < 4; ++j) v[q][j] = *(const f32x4*)(C.out + O_Y + (size_t)(row0 + q) * DM + 256 * j + 4 * C.lane); }
#pragma unroll
        for (int q = 0; q < 4; ++q)
#pragma unroll
            for (int j = 0; j < 4; ++j) { const int c = 256 * j + 4 * C.lane; __builtin_nontemporal_store(v[q][j] * rs[q] * *(const f32x4*)(gf + c), (f32x4*)(C.out + O_Y + (size_t)(row0 + q) * DM + c)); } }
}

constexpr int LDS_BYTES = 131072 + 1024;
constexpr int NPHASE = 15;
__device__ __forceinline__ void run_phases(const Args& args, const int lo, const int hi) {
    extern __shared__ __attribute__((aligned(16))) unsigned char lds_raw[];
    Ctx C; C.in = args.in; C.out = args.out; C.ws = args.ws; C.lds = (LAS unsigned char*)lds_raw;
    C.tid = threadIdx.x; C.lane = C.tid & 63; C.wave = __builtin_amdgcn_readfirstlane(C.tid >> 6); C.G = gridDim.x; C.bx = blockIdx.x;
    C.vcu = (C.G % 8 == 0) ? (C.bx % 8) * (C.G / 8) + C.bx / 8 : C.bx;
    unsigned char* ws = args.ws; float* st = (float*)(ws + WS_STAT);
    float* SS1 = st, *SSQ = st + MT, *SSKV = st + 2 * MT, *SS2 = st + 3 * MT, *SS3 = st + 4 * MT, *SS0 = st + 5 * MT;
#ifndef MK_MASK
#define MK_MASK 0x1ffff
#endif
#define IN(k) (((MK_MASK >> (k)) & 1) && INX(k))
#define INX(k) ((k) >= 15 ? (hi - lo > 1 ? (lo <= 8 && 8 < hi) : (lo == (k))) : (lo <= (k) && (k) < hi))
#define SEAM(k) do { if (IN(k) && IN((k) + 1)) { xcd_barrier(xbar); } } while (0)
#define BF(off) ((bf16_t*)(ws + (off)))
    volatile LAS unsigned* bst = (volatile LAS unsigned*)(C.lds + 131072);
    if (C.tid < 2) bst[C.tid] = 0u;
    __syncthreads();
    XcdBarrier xbar; xbar.bar = (unsigned*)(ws + WS_BAR); xbar.x = 0; xbar.st = bst;
    if (hi - lo > 1) xbar = xcd_barrier_post((unsigned*)(ws + WS_BAR), bst);
    pg8::StaticOrder S;
    if (IN(0)) { p0_prologue(C); } SEAM(0);
    if (IN(1)) { pg8::Gemm g{BF(WS_AB), BF(W_13A), MT, 5632, 1024, 1024, 1024, 0, nullptr, nullptr}; S.init(MT, 5632, g.K, C.G, C.bx); EpiSwiglu E{BF(WS_ZA), SS0}; pg8::gemm_phase(C.lds, g, S, E); } SEAM(1);
    if (IN(2)) { pg8::Gemm g{BF(WS_ZA), BF(W_2A), MT, 1024, DFF, DFF, DFF, 0, (float*)(ws + WS_XC), (unsigned*)(ws + WS_CNT)}; S.init(MT, 1024, g.K, C.G, C.bx, 2); EpiResid<true> E{args.in[0], args.in[1], args.out, BF(WS_AB), SS1, 0.5f}; pg8::gemm_phase(C.lds, g, S, E); } SEAM(2);
    if (IN(3)) { pg8::Gemm g{BF(WS_AB), BF(W_IN), MT, ZW, 1024, 1024, 1024, 0, nullptr, nullptr}; S.init(MT, ZW, g.K, C.G, C.bx); EpiWin E{SS1, BF(WS_ZA), BF(WS_ZRX), BF(WS_ZRG), ws + WS_ZG8, SSQ, SSKV}; pg8::gemm_phase(C.lds, g, S, E); } SEAM(3);
    if (IN(4)) { p4_mid(C); } SEAM(4);
    if (IN(5)) { pg8::Gemm g{BF(WS_XC), BF(W_G), MT, 2048, 128, 1024, 128, 128, nullptr, nullptr}; S.init(MT, 2048, g.K, C.G, C.bx); EpiGates E{BF(WS_XC), args.in[20], args.in[22], (const float*)(ws + WS_SP), BF(WS_AB), BF(WS_ZRX)}; pg8::gemm_phase(C.lds, g, S, E); } SEAM(5);
    if (IN(6)) { p6_scan1(C); } SEAM(6);
    if (IN(7)) { p7_scan3(C); } SEAM(7);
    if (IN(8)) { pg8::Gemm g{BF(WS_ZA), BF(W_UQ), MT, 768, 384, 768, 384, 0, nullptr, nullptr}; S.init(MT, 768, g.K, C.G, C.bx); EpiQ E{SSQ, (const f32x2*)(ws + WS_CS), BF(WS_ZRX)}; pg8::gemm_phase(C.lds, g, S, E); }
    if (IN(15)) { pg8::Gemm g{BF(WS_CKV), BF(W_KV), KVROWS, 512, 256, 256, 256, 0, nullptr, nullptr}; S.init(KVROWS, 512, g.K, C.G, (C.bx + 120) % C.G); EpiPlain E{BF(WS_ZRG), 512}; pg8::gemm_phase(C.lds, g, S, E); }
    if (IN(16)) { pg8::Gemm g{BF(W_KV) + 512 * 256, BF(WS_CKV), 512, KVROWS, 256, 256, 256, 0, nullptr, nullptr}; S.init(512, KVROWS, g.K, C.G, (C.bx + 72) % C.G); EpiPlain E{BF(WS_AB), KVROWS}; pg8::gemm_phase(C.lds, g, S, E); }
    SEAM(8);
    if (IN(9)) { p9_attn(C); } SEAM(9);
#if MK_DUP == 9
    if (IN(9)) { p9_attn(C); } SEAM(9);
#endif
    if (IN(10)) {
        { pg8::Gemm g{BF(WS_ZA), BF(W_OA), MT, 1024, 512, 512, 512, 0, nullptr, nullptr}; S.init(MT, 1024, g.K, C.G, C.bx); EpiMerge<0> E{ws + WS_ZG8, BF(WS_ZRX), BF(WS_ZRG)}; pg8::gemm_phase(C.lds, g, S, E); }
        { pg8::Gemm g{BF(WS_XC), BF(W_OR), MT, 1024, 1024, 1024, 1024, 0, nullptr, nullptr}; S.init(MT, 1024, g.K, C.G, C.bx); EpiMerge<1> E{ws + WS_ZG8, BF(WS_ZRX), BF(WS_ZRG)}; pg8::gemm_phase(C.lds, g, S, E); }
    } SEAM(10);
    if (IN(11)) { pg8::Gemm g{BF(WS_ZRG), BF(W_OUT), MT, 1024, 1024, 1024, 1024, 0, (float*)(ws + WS_XC), (unsigned*)(ws + WS_CNT) + 8}; S.init(MT, 1024, g.K, C.G, C.bx, 2); EpiResid<true> E{args.out, args.out + (size_t)MP * DM, args.out, BF(WS_AB), SS2, 1.0f}; pg8::gemm_phase(C.lds, g, S, E); } SEAM(11);
    if (IN(12)) { pg8::Gemm g{BF(WS_AB), BF(W_13B), MT, 5632, 1024, 1024, 1024, 0, nullptr, nullptr}; S.init(MT, 5632, g.K, C.G, C.bx); EpiSwiglu E{BF(WS_ZA), SS2}; pg8::gemm_phase(C.lds, g, S, E); } SEAM(12);
    if (IN(13)) { pg8::Gemm g{BF(WS_ZA), BF(W_2B), MT, 1024, DFF, DFF, DFF, 0, (float*)(ws + WS_XC), (unsigned*)(ws + WS_CNT) + 16}; S.init(MT, 1024, g.K, C.G, C.bx, 2); EpiResid<false> E{args.out, args.out + (size_t)MP * DM, args.out, nullptr, SS3, 0.5f}; pg8::gemm_phase(C.lds, g, S, E); } SEAM(13);
    if (IN(14)) { p14_final(C); }
#undef IN
#undef SEAM
#undef BF
}
#if MK_ONE_LAUNCH
__global__ void __launch_bounds__(512, 2) mk_fwd(Args args) {
    run_phases(args, 0, NPHASE);
    if (args.ph_hi > NPHASE + 100) cg::this_grid().sync();
}
#endif
template <int P> __global__ void __launch_bounds__(512, 2) mk_phase(Args args) { run_phases(args, P, P + 1); }

extern "C" void kernel_launch(void* const* d_in, const int* in_sizes, int n_in, void* d_out, int out_size, void* d_ws, size_t ws_size, hipStream_t stream) {
    static int grid = 0;
    if (grid == 0) {
        if (n_in != 31 || ws_size < WS_END) { fprintf(stderr, "kernel_launch: unexpected n_in %d / ws %zu (need %zu)\n", n_in, ws_size, (size_t)WS_END); grid = -1; return; }
        int dev = 0, cus = 0, per_cu = 0;
        (void)hipGetDevice(&dev); (void)hipDeviceGetAttribute(&cus, hipDeviceAttributeMultiprocessorCount, dev);
#if MK_ONE_LAUNCH
        if (hipFuncSetAttribute((const void*)mk_fwd, hipFuncAttributeMaxDynamicSharedMemorySize, LDS_BYTES) != hipSuccess) { fprintf(stderr, "kernel_launch: hipFuncSetAttribute failed\n"); grid = -1; return; }
        if (hipOccupancyMaxActiveBlocksPerMultiprocessor(&per_cu, (const void*)mk_fwd, 512, LDS_BYTES) != hipSuccess || per_cu < 1) { fprintf(stderr, "kernel_launch: occupancy query says %d\n", per_cu); per_cu = 1; }
#else
#define SA(P) (void)hipFuncSetAttribute((const void*)mk_phase<P>, hipFuncAttributeMaxDynamicSharedMemorySize, LDS_BYTES);
        SA(0) SA(1) SA(2) SA(3) SA(4) SA(5) SA(6) SA(7) SA(8) SA(9) SA(10) SA(11) SA(12) SA(13) SA(14) SA(15) SA(16)
#undef SA
#endif
        (void)hipGetLastError();
        grid = cus * 1;
    }
    if (grid < 0) return;
    if (hipMemsetAsync((char*)d_ws + WS_BAR, 0, 16384, stream) != hipSuccess) { fprintf(stderr, "kernel_launch: memset failed\n"); return; }
    Args a{};
    for (int i = 0; i < 31; ++i) a.in[i] = (const float*)d_in[i];
    a.out = (float*)d_out; a.ws = (unsigned char*)d_ws;
#if MK_ONE_LAUNCH
    a.ph_lo = 0; a.ph_hi = NPHASE;
    void* kargs[] = {&a};
    hipError_t e = hipLaunchCooperativeKernel((const void*)mk_fwd, dim3(grid), dim3(512), kargs, LDS_BYTES, stream);
    if (e != hipSuccess) fprintf(stderr, "cooperative launch failed: %s (grid %d)\n", hipGetErrorString(e), grid);
#else
#define LP(P) hipLaunchKernelGGL(mk_phase<P>, dim3(grid), dim3(512), LDS_BYTES, stream, a);
    LP(0) LP(1) LP(2) LP(3) LP(4) LP(5) LP(6) LP(7) LP(8) LP(15) LP(16) LP(9) LP(10) LP(11) LP(12) LP(13) LP(14)
#undef LP
#endif
}
```
